# Optimizing an MI355X kernel written in HIP

```python
import math
import jax, jax.numpy as jnp
from jax import lax
import numpy as np


D_MODEL = 2048
BATCH = 2
SEQ = 8192
DEPTH = 1

CHUNK = 64
QBLOCK = 128
N_MEM = 256
EPS = 1e-6

GLA_HEADS = 4
GLA_DK = D_MODEL // 2 // GLA_HEADS
GLA_DV = D_MODEL // GLA_HEADS
GLA_GATE_RANK = 16
GLA_TAU = 16.0

DSA_HEADS = 16
DSA_DH = D_MODEL // DSA_HEADS
DSA_DV = D_MODEL // DSA_HEADS
DSA_LATENT = D_MODEL // 8
IDX_HEADS = 16
IDX_DIM = 128
INDEX_TOPK = 256

REL_BUCKETS = 32
REL_MAX_DIST = 128

XATTN_HEADS = 4
XATTN_DH = D_MODEL // XATTN_HEADS

D_FF = ((8 * D_MODEL // 3 + 255) // 256) * 256

IN_SPLITS = (
    GLA_HEADS * GLA_DK,
    GLA_HEADS * GLA_DK,
    GLA_HEADS * GLA_DV,
    GLA_HEADS * GLA_DV,
    GLA_GATE_RANK,
    DSA_HEADS * DSA_DH,
    DSA_LATENT,
    IDX_HEADS * IDX_DIM,
    IDX_DIM,
    IDX_HEADS,
    D_MODEL,
    D_MODEL,
)
IN_COLS = sum(IN_SPLITS)

kernel_name = 'hybrid_gla_dsa_stream_block'


def rms_norm(x, gain):
    xf = x.astype(jnp.float32)
    y = xf * lax.rsqrt(jnp.mean(xf * xf, axis=-1, keepdims=True) + EPS)
    return (y * gain.astype(jnp.float32)).astype(x.dtype)


def layer_norm(x, w, b):
    xf = x.astype(jnp.float32)
    mu = jnp.mean(xf, axis=-1, keepdims=True)
    xc = xf - mu
    var = jnp.mean(xc * xc, axis=-1, keepdims=True)
    return (xc * lax.rsqrt(var + EPS) * w.astype(jnp.float32) + b.astype(jnp.float32)).astype(x.dtype)


def split_columns(y, sizes):
    parts = []
    off = 0
    for s in sizes:
        parts.append(y[..., off:off + s])
        off += s
    return parts


def t5_bucket(rel):
    half = REL_BUCKETS // 2
    max_exact = half // 2
    ret = jnp.where(rel > 0, half, 0)
    n = jnp.abs(rel)
    nf = jnp.maximum(n, 1).astype(jnp.float32)
    large = max_exact + (jnp.log(nf / max_exact) / math.log(REL_MAX_DIST / max_exact)
                         * (half - max_exact)).astype(jnp.int32)
    large = jnp.minimum(large, half - 1)
    return ret + jnp.where(n < max_exact, n, large)


def gla_mixer(q, k, v, r, a_low, w_a2, b_a, out_norm):
    B, S, _ = q.shape
    nc = S // CHUNK
    f32 = jnp.float32
    log_a = jax.nn.log_sigmoid((a_low @ w_a2 + b_a).astype(f32)) / GLA_TAU

    def to_chunks(t, d):
        return t.astype(f32).reshape(B, nc, CHUNK, GLA_HEADS, d).transpose(1, 0, 3, 2, 4)

    qc = to_chunks(q, GLA_DK) * (GLA_DK ** -0.5)
    kc = to_chunks(k, GLA_DK)
    vc = to_chunks(v, GLA_DV)
    bc = jnp.cumsum(to_chunks(log_a, GLA_DK), axis=3)
    lower = jnp.tril(jnp.ones((CHUNK, CHUNK), dtype=bool))

    def step(state, inp):
        qi, ki, vi, bi = inp
        eb = jnp.exp(bi)
        ebi = jnp.exp(-bi)
        q_fwd = qi * eb
        a_lo = jnp.einsum('bhtd,bhsd->bhts', q_fwd, ki * ebi)
        a_up = jnp.einsum('bhtd,bhsd->bhts', qi * ebi, ki * eb)
        scores = jnp.where(lower, a_lo, a_up)
        o = (jnp.einsum('bhts,bhsv->bhtv', scores, vi)
             + jnp.einsum('bhtd,bhdv->bhtv', q_fwd, state))
        b_last = bi[:, :, -1, :]
        state = (jnp.exp(b_last)[..., None] * state
                 + jnp.einsum('bhsd,bhsv->bhdv', ki * jnp.exp(b_last[:, :, None, :] - bi), vi))
        return state, o

    state0 = jnp.zeros((B, GLA_HEADS, GLA_DK, GLA_DV), f32)
    _, o = lax.scan(step, state0, (qc, kc, vc, bc))
    o = o.transpose(1, 0, 3, 2, 4).reshape(B, S, GLA_HEADS, GLA_DV)
    o = rms_norm(o, out_norm).reshape(B, S, GLA_HEADS * GLA_DV)
    o = o * jax.nn.silu(r.astype(f32))
    return o.astype(q.dtype)


def dsa_mixer(q, c_lat, q_idx, k_idx, w_idx, w_uk, w_uv, rel_bias):
    B, S, _ = q.shape
    dtype = q.dtype
    f32 = jnp.float32
    top_k = min(INDEX_TOPK, S // 4)
    q = q.reshape(B, S, DSA_HEADS, DSA_DH)
    q_idx = q_idx.reshape(B, S, IDX_HEADS, IDX_DIM)
    w_idx = w_idx * (IDX_HEADS ** -0.5 * IDX_DIM ** -0.5)
    key_chunk = jnp.arange(S) // CHUNK
    gather = jax.vmap(lambda table, idx: table[idx])

    def block(start):
        qb = lax.dynamic_slice_in_dim(q, start, QBLOCK, axis=1)
        qib = lax.dynamic_slice_in_dim(q_idx, start, QBLOCK, axis=1)
        wb = lax.dynamic_slice_in_dim(w_idx, start, QBLOCK, axis=1)
        t_pos = start + jnp.arange(QBLOCK)
        t_chunk = t_pos // CHUNK
        dots = jnp.einsum('bqhd,bsd->bqhs', qib, k_idx)
        score = jnp.einsum('bqh,bqhs->bqs', wb, jax.nn.relu(dots)).astype(f32)
        score = jnp.where(key_chunk[None, None, :] <= t_chunk[None, :, None], score, -jnp.inf)
        _, idx = lax.top_k(score, top_k)
        valid = (idx // CHUNK) <= t_chunk[None, :, None]
        c_sel = gather(c_lat, idx)
        q_lat = jnp.einsum('bqhd,hdr->bqhr', qb, w_uk)
        logits = jnp.einsum('bqhr,bqkr->bqhk', q_lat, c_sel).astype(f32) * (DSA_DH ** -0.5)
        bias = rel_bias[t5_bucket(idx - t_pos[None, :, None])]
        logits = logits + jnp.moveaxis(bias, -1, 2).astype(f32)
        logits = jnp.where(valid[:, :, None, :], logits, -jnp.inf)
        p = jax.nn.softmax(logits, axis=-1).astype(dtype)
        o_lat = jnp.einsum('bqhk,bqkr->bqhr', p, c_sel)
        o = jnp.einsum('bqhr,hrv->bqhv', o_lat, w_uv)
        return o.reshape(B, QBLOCK, DSA_HEADS * DSA_DV)

    out = lax.map(block, jnp.arange(S // QBLOCK, dtype=jnp.int32) * QBLOCK)
    return out.transpose(1, 0, 2, 3).reshape(B, S, DSA_HEADS * DSA_DV)


def memory_cross_attention(u, mem_n, w_q, w_kv, w_o):
    B, S, D = u.shape
    M = mem_n.shape[1]
    q = (u @ w_q).reshape(B, S, XATTN_HEADS, XATTN_DH)
    k, v = jnp.split(mem_n @ w_kv, 2, axis=-1)
    k = k.reshape(B, M, XATTN_HEADS, XATTN_DH)
    v = v.reshape(B, M, XATTN_HEADS, XATTN_DH)
    logits = jnp.einsum('bshd,bmhd->bhsm', q, k).astype(jnp.float32) * (XATTN_DH ** -0.5)
    p = jax.nn.softmax(logits, axis=-1).astype(u.dtype)
    o = jnp.einsum('bhsm,bmhd->bshd', p, v).reshape(B, S, D)
    return o @ w_o


def swiglu(u, w_gate, w_up, w_down):
    return (jax.nn.silu(u @ w_gate) * (u @ w_up)) @ w_down


def setup_inputs(seed: int = 0) -> dict:
    key = jax.random.key(seed)
    ks = jax.random.split(key, 32)
    L = DEPTH
    D = D_MODEL

    def nrm(k, shape, scale):
        return jax.random.normal(k, shape, jnp.float32) * scale

    def gain(k, shape):
        return 1.0 + 0.02 * jax.random.normal(k, shape, jnp.float32)

    return {
        'x': nrm(ks[0], (BATCH, SEQ, D), 1.0),
        'mem': nrm(ks[1], (BATCH, N_MEM, D), 1.0),
        'w_in': nrm(ks[2], (L, D, IN_COLS), D ** -0.5),
        'gla_w_a2': nrm(ks[3], (L, GLA_GATE_RANK, GLA_HEADS * GLA_DK), GLA_GATE_RANK ** -0.5),
        'gla_b_a': nrm(ks[4], (L, GLA_HEADS * GLA_DK), 0.1),
        'gla_out_norm': gain(ks[5], (L, GLA_DV)),
        'dsa_w_uk': nrm(ks[6], (L, DSA_HEADS, DSA_DH, DSA_LATENT), DSA_LATENT ** -0.5),
        'dsa_w_uv': nrm(ks[7], (L, DSA_HEADS, DSA_LATENT, DSA_DV), DSA_LATENT ** -0.5),
        'dsa_latent_norm': gain(ks[8], (L, DSA_LATENT)),
        'idx_k_norm_w': gain(ks[9], (L, IDX_DIM)),
        'idx_k_norm_b': nrm(ks[10], (L, IDX_DIM), 0.02),
        'rel_bias': nrm(ks[11], (REL_BUCKETS, DSA_HEADS), 0.2),
        'w_gla_branch': nrm(ks[12], (L, GLA_HEADS * GLA_DV, D), (GLA_HEADS * GLA_DV) ** -0.5),
        'w_dsa_branch': nrm(ks[13], (L, DSA_HEADS * DSA_DV, D), (DSA_HEADS * DSA_DV) ** -0.5),
        'w_mix_out': nrm(ks[14], (L, D, D), D ** -0.5),
        'mix_pre_norm': gain(ks[15], (L, D)),
        'mix_post_norm': gain(ks[16], (L, D)),
        'xa_pre_norm': gain(ks[17], (L, D)),
        'xa_post_norm': gain(ks[18], (L, D)),
        'xa_mem_norm': gain(ks[19], (L, D)),
        'w_xa_q': nrm(ks[20], (L, D, D), D ** -0.5),
        'w_xa_kv': nrm(ks[21], (L, D, 2 * D), D ** -0.5),
        'w_xa_o': nrm(ks[22], (L, D, D), D ** -0.5),
        'ffn_pre_norm': gain(ks[23], (L, D)),
        'ffn_post_norm': gain(ks[24], (L, D)),
        'w_ffn_gate': nrm(ks[25], (L, D, D_FF), D ** -0.5),
        'w_ffn_up': nrm(ks[26], (L, D, D_FF), D ** -0.5),
        'w_ffn_down': nrm(ks[27], (L, D_FF, D), D_FF ** -0.5),
    }


def reference(x, mem, w_in, gla_w_a2, gla_b_a, gla_out_norm, dsa_w_uk, dsa_w_uv, dsa_latent_norm,
              idx_k_norm_w, idx_k_norm_b, rel_bias, w_gla_branch, w_dsa_branch, w_mix_out,
              mix_pre_norm, mix_post_norm, xa_pre_norm, xa_post_norm, xa_mem_norm,
              w_xa_q, w_xa_kv, w_xa_o, ffn_pre_norm, ffn_post_norm,
              w_ffn_gate, w_ffn_up, w_ffn_down):
    h = x
    for layer in range(DEPTH):
        u = rms_norm(h, mix_pre_norm[layer])
        proj = u @ w_in[layer]
        (g_q, g_k, g_v, g_r, g_a, d_q, d_c, i_q, i_k, i_w, gate_gla, gate_dsa) = split_columns(proj, IN_SPLITS)
        y_gla = gla_mixer(g_q, g_k, g_v, g_r, g_a, gla_w_a2[layer], gla_b_a[layer], gla_out_norm[layer])
        c_lat = rms_norm(d_c, dsa_latent_norm[layer])
        k_idx = layer_norm(i_k, idx_k_norm_w[layer], idx_k_norm_b[layer])
        y_dsa = dsa_mixer(d_q, c_lat, i_q, k_idx, i_w, dsa_w_uk[layer], dsa_w_uv[layer], rel_bias)
        merged = (jax.nn.sigmoid(gate_gla) * (y_gla @ w_gla_branch[layer])
                  + jax.nn.sigmoid(gate_dsa) * (y_dsa @ w_dsa_branch[layer]))
        h = h + rms_norm(merged @ w_mix_out[layer], mix_post_norm[layer])
        u = rms_norm(h, xa_pre_norm[layer])
        mem_n = rms_norm(mem, xa_mem_norm[layer])
        y = memory_cross_attention(u, mem_n, w_xa_q[layer], w_xa_kv[layer], w_xa_o[layer])
        h = h + rms_norm(y, xa_post_norm[layer])
        u = rms_norm(h, ffn_pre_norm[layer])
        y = swiglu(u, w_ffn_gate[layer], w_ffn_up[layer], w_ffn_down[layer])
        h = h + rms_norm(y, ffn_post_norm[layer])
    return h
```

```cpp
#include <hip/hip_runtime.h>
#include <cstdio>
#include <cstdint>

#define GAS __attribute__((address_space(1)))
#define LAS __attribute__((address_space(3)))
typedef unsigned short bf16;
typedef unsigned short u16;
typedef short bf16x8 __attribute__((ext_vector_type(8)));
typedef short bf16x4 __attribute__((ext_vector_type(4)));
typedef float f32x4 __attribute__((ext_vector_type(4)));
typedef float f32x16 __attribute__((ext_vector_type(16)));
typedef float f32x2 __attribute__((ext_vector_type(2)));
typedef unsigned u32x4 __attribute__((ext_vector_type(4)));
typedef unsigned u32x2 __attribute__((ext_vector_type(2)));
typedef short v4i16_t __attribute__((ext_vector_type(4)));
typedef _Float16 f16;

#define G2_XSYNC 0
constexpr int DM = 2048, NB = 2, SEQ = 8192, M = NB * SEQ, CHUNK = 64, NCH = SEQ / CHUNK;
constexpr int NMEM = 256, GH = 4, GDK = 256, GDV = 512, GRANK = 16;
constexpr int DH = 16, DDH = 128, DLAT = 256, IH = 16, IDIM = 128, TOPK = 256;
constexpr int XH = 4, XDH = 512, DFF = 5632, INCOLS = 14752;
constexpr float EPS = 1e-6f;
constexpr int NWAVES = 8, NTHR = 512;

constexpr size_t MiB = 1u << 20;
constexpr size_t WS_CTL = 0, CTL_ZERO_BYTES = 1 * MiB;
constexpr size_t WS_BTUK = 1 * MiB;
constexpr size_t WS_BTUV = 3 * MiB;
constexpr size_t WS_MEMN = 5 * MiB;
constexpr size_t WS_CLAT = 7 * MiB;
constexpr size_t WS_KIDX = 15 * MiB;
constexpr size_t WS_IDX = 19 * MiB;
constexpr size_t WS_DCRAW = 27 * MiB;
constexpr size_t WS_MISC = 43 * MiB;
constexpr size_t WS_KV = 122 * MiB;
constexpr size_t WS_VT = 126 * MiB;
constexpr size_t WS_WXKV0 = 448 * MiB;
constexpr size_t WS_S1 = 64 * MiB, WS_S2 = 128 * MiB, WS_S3 = 192 * MiB, WS_S4 = 256 * MiB, WS_S5 = 320 * MiB, WS_S6 = 384 * MiB, WS_S7 = 448 * MiB, WS_END = 512 * MiB;
constexpr size_t WS_W1A = WS_S1;
constexpr size_t WS_W1B = WS_S1 + 18 * MiB;
constexpr size_t WS_SC = WS_S1;
constexpr size_t WS_WGB = WS_S1 + 8 * MiB, WS_WDB = WS_S1 + 16 * MiB, WS_WMIX = WS_S1 + 24 * MiB;
constexpr size_t WS_U0 = WS_S2;
constexpr size_t WS_QFP = WS_S2, WS_KDT = WS_S2 + 32 * MiB;
constexpr size_t WS_IQ = WS_S3;
constexpr size_t WS_DQ = WS_S4;
constexpr size_t WS_SCR = WS_S5;
constexpr size_t WS_GR = WS_S5, WS_GVT = WS_S6;
constexpr size_t WS_WXQ = WS_S6, WS_WXKV = WS_S6 + 8 * MiB, WS_WXO = WS_S6 + 24 * MiB;
constexpr size_t WS_YDSA = WS_S7;
constexpr size_t WS_WFGU = WS_S4;
constexpr size_t WS_WFD = WS_S4 + 44 * MiB;
constexpr size_t WS_HID = 328 * MiB;
static_assert(WS_HID + (size_t)M * DFF * 2 <= WS_END && WS_MISC + 16 * MiB <= 64 * MiB && WS_DCRAW + 16 * MiB <= WS_MISC && WS_IDX + 8 * MiB <= WS_DCRAW && WS_KIDX + 4 * MiB <= WS_IDX && WS_CLAT + 8 * MiB <= WS_KIDX, "ws map");
constexpr int CW_TMO = 0, CW_BAR = 4096;

constexpr int LDS_BYTES = 163840, MISC_OFF = LDS_BYTES - 256;

#define RLX_AGENT __ATOMIC_RELAXED, __HIP_MEMORY_SCOPE_AGENT
#define LDS_WAIT() asm volatile("s_waitcnt lgkmcnt(0)" ::: "memory")
#define VM_WAIT() asm volatile("s_waitcnt vmcnt(0)" ::: "memory")
typedef __bf16 bf16x2_t __attribute__((ext_vector_type(2)));
__device__ __forceinline__ unsigned cvt_pk_bf16(float lo, float hi) { const f32x2 v = {lo, hi}; const bf16x2_t b = __builtin_convertvector(v, bf16x2_t); return __builtin_bit_cast(unsigned, b); }
__device__ __forceinline__ float bf_lo(unsigned w) { return __uint_as_float(w << 16); }
__device__ __forceinline__ float bf_hi(unsigned w) { return __uint_as_float(w & 0xffff0000u); }
__device__ __forceinline__ float bf2f(bf16 h) { return __uint_as_float((unsigned)h << 16); }
__device__ __forceinline__ float sigmoidf_(float x) { return __frcp_rn(1.0f + __expf(-x)); }
__device__ __forceinline__ int fresh_lane() { unsigned z; asm volatile("v_mov_b32 %0, 0" : "=v"(z)); return (int)__builtin_amdgcn_mbcnt_hi(~0u, __builtin_amdgcn_mbcnt_lo(~0u, z)); }
template <int O> __device__ __forceinline__ float swz_(float v) { return __int_as_float(__builtin_amdgcn_ds_swizzle(__float_as_int(v), (O << 10) | 0x1F)); }
__device__ __forceinline__ float x32_sum(float v) { const auto r = __builtin_amdgcn_permlane32_swap(__float_as_uint(v), __float_as_uint(v), false, false); return __uint_as_float(r[0]) + __uint_as_float(r[1]); }
__device__ __forceinline__ float x32_max(float v) { const auto r = __builtin_amdgcn_permlane32_swap(__float_as_uint(v), __float_as_uint(v), false, false); return fmaxf(__uint_as_float(r[0]), __uint_as_float(r[1])); }
__device__ __forceinline__ float x16_sum(float v) { return v + swz_<16>(v); }
__device__ __forceinline__ float x16_max(float v) { return fmaxf(v, swz_<16>(v)); }
__device__ __forceinline__ float wave_sum(float v) {
    v += swz_<1>(v); v += swz_<2>(v); v += swz_<4>(v); v += swz_<8>(v); v += swz_<16>(v); return x32_sum(v);
}

namespace pg8 {
typedef unsigned short bf16_t;
constexpr int BM = 256, BK = 64, HALF = 128, HTB = HALF * BK * 2, STAGE_BYTES = 8 * HTB, NXCD = 8, WGM = 8;
__host__ __device__ __forceinline__ int lds_byte(int r, int c) { const int st = (r >> 4) * 2 + (c >> 5), rr = r & 15, cc = c & 31, ob = rr * 64 + cc * 2; return st * 1024 + (ob ^ (((ob >> 9) & 1) << 5)); }
__host__ __device__ __forceinline__ void stage_rc(int b, int& R, int& C) { const int st = b / 1024, sb = b % 1024, swz = sb ^ (((sb >> 9) & 1) << 5); R = (st >> 1) * 16 + swz / 64; C = (st & 1) * 32 + (swz % 64) / 2; }
__host__ __device__ __forceinline__ int perm32(int rho) { const int n = rho >> 4, i = rho & 15; return 8 * (i >> 2) + 4 * n + (i & 3); }

struct Unit { int pm, pn; };
struct Gemm { const bf16_t* A; const bf16_t* Bt; int M, N, K, lda, acs, ash; };

struct StaticOrder {
    int nM, nN, nwg, G, c;
    __host__ __device__ void init(int M_, int N_, int G_, int c_) { nM = M_ / BM; nN = N_ / BM; nwg = nM * nN; G = G_; c = c_; }
    __host__ __device__ bool next(int i, Unit& u) const {
        const long L = (long)i * G + c; if (L >= nwg) return false;
        int wgid = (int)L; { const int q = nwg / NXCD, r = nwg % NXCD, xcd = wgid % NXCD, off = wgid / NXCD; wgid = (xcd < r ? xcd * (q + 1) : r * (q + 1) + (xcd - r) * q) + off; }
        const int nig = WGM * nN, gid = wgid / nig, fm = gid * WGM, gsz = (nM - fm) < WGM ? (nM - fm) : WGM;
        u.pm = fm + ((wgid % nig) % gsz); u.pn = (wgid % nig) / gsz; return true;
    }
};

template <class Epi, class Sched, bool ALIGN_EPI = true>
__device__ __forceinline__ void gemm_phase(LAS unsigned char* lds, const Gemm g, const Sched& S, const Epi& E, const int wid) {
    const int lane = fresh_lane(), tid = wid * 64 + lane, wr = wid >> 2, wc = wid & 3, fr = lane & 15, fq = lane >> 4;
    const int K = g.K, nt = K / BK, lda = g.lda;
    unsigned voffA[2], voffB[2];
#pragma unroll
    for (int i = 0; i < 2; ++i) { int R, C; stage_rc(tid * 16 + i * 8192, R, C); const int Rb = (R & ~31) + perm32(R & 31);
        voffA[i] = (unsigned)(R * lda + C) * 2u; voffB[i] = (unsigned)(Rb * K + C) * 2u; }
    const size_t kstep = (size_t)(BK * 2);
    const size_t hstepA = (size_t)HALF * lda * 2, hstepB = (size_t)HALF * K * 2;
    const size_t tstepA = 2 * hstepA, tstepB = 2 * hstepB;
    const unsigned ldsw = (unsigned)wid * 1024u;
    const int aoff = lds_byte(wr * 64 + fr, fq * 8), boff = lds_byte(wc * 32 + fr, fq * 8);
#define PG8_SA(b, h) (((b) * 2 + (h)) * HTB)
#define PG8_SB(b, h) ((4 + (b) * 2 + (h)) * HTB)
#define PG8_STAGE(bufoff, gbase, voff) do { _Pragma("unroll") for (int _i = 0; _i < 2; ++_i) \
        __builtin_amdgcn_global_load_lds((const unsigned*)((const char*)(gbase) + (voff)[_i]), (LAS unsigned*)(lds + (bufoff) + ldsw + _i * 8192), 16, 0, 0); } while (0)
#define PG8_LDA(dst, b, h) do { _Pragma("unroll") for (int m = 0; m < 4; ++m) _Pragma("unroll") for (int k = 0; k < 2; ++k) dst[m][k] = *(const LAS bf16x8*)(lds + PG8_SA(b, h) + aoff + m * 2048 + k * 1024); } while (0)
#define PG8_LDB(dst, b, h) do { _Pragma("unroll") for (int n = 0; n < 2; ++n) _Pragma("unroll") for (int k = 0; k < 2; ++k) dst[n][k] = *(const LAS bf16x8*)(lds + PG8_SB(b, h) + boff + n * 2048 + k * 1024); } while (0)
#define PG8_MMA(ai, bj, At, Bt) do { __builtin_amdgcn_s_setprio(1); _Pragma("unroll") for (int m = 0; m < 4; ++m) _Pragma("unroll") for (int n = 0; n < 2; ++n) _Pragma("unroll") for (int k = 0; k < 2; ++k) \
        acc[ai][bj][m][n] = __builtin_amdgcn_mfma_f32_16x16x32_bf16(Bt[n][k], At[m][k], acc[ai][bj][m][n], 0, 0, 0); __builtin_amdgcn_s_setprio(0); } while (0)
#define PG8_WAIT_V(n) asm volatile("s_waitcnt vmcnt(" #n ")" ::: "memory")
#define PG8_WAIT_L(n) asm volatile("s_waitcnt lgkmcnt(" #n ")" ::: "memory")
#define PG8_BAR __builtin_amdgcn_s_barrier()
#define PG8_SCHED __builtin_amdgcn_sched_barrier(0)
    Unit cur, nxt; int ui = 0;
    if (!S.next(0, cur)) return;
    f32x4 acc[2][2][4][2];
#pragma unroll
    for (int a = 0; a < 2; ++a)
#pragma unroll
        for (int b = 0; b < 2; ++b)
#pragma unroll
            for (int m = 0; m < 4; ++m)
#pragma unroll
                for (int n = 0; n < 2; ++n) acc[a][b][m][n] = (f32x4){0.f, 0.f, 0.f, 0.f};
    bf16x8 At[4][2], B0[2][2], B1[2][2];
    const char* cA = (const char*)g.A + (size_t)cur.pm * tstepA + (size_t)((cur.pn >> g.ash) * g.acs) * 2; const char* cB = (const char*)g.Bt + (size_t)cur.pn * tstepB;
    PG8_STAGE(PG8_SB(0, 0), cB, voffB); PG8_STAGE(PG8_SB(0, 1), cB + hstepB, voffB); PG8_STAGE(PG8_SA(0, 0), cA, voffA); PG8_STAGE(PG8_SA(0, 1), cA + hstepA, voffA);
    if (wr == 1) PG8_BAR;
    PG8_WAIT_V(2); PG8_BAR;
    PG8_STAGE(PG8_SB(1, 0), cB + kstep, voffB); PG8_STAGE(PG8_SA(1, 0), cA + kstep, voffA); PG8_STAGE(PG8_SB(1, 1), cB + hstepB + kstep, voffB);
    PG8_WAIT_V(6); PG8_BAR;
    for (;;) {
        const bool has_next = S.next(ui + 1, nxt);
        const char* nA = has_next ? (const char*)g.A + (size_t)nxt.pm * tstepA + (size_t)((nxt.pn >> g.ash) * g.acs) * 2 : cA; const char* nB = has_next ? (const char*)g.Bt + (size_t)nxt.pn * tstepB : cB;
#pragma unroll 1
        for (int t = 0; t < nt; t += 2) {
            const bool last = (t == nt - 2);
            const char* a1 = cA + (size_t)(t + 1) * kstep;
            const char* a2 = last ? nA : cA + (size_t)(t + 2) * kstep; const char* b2 = last ? nB : cB + (size_t)(t + 2) * kstep;
            const char* a3 = a2 + kstep; const char* b3 = b2 + kstep;
            PG8_LDB(B0, 0, 0); PG8_LDB(B1, 0, 1); PG8_SCHED; PG8_LDA(At, 0, 0); PG8_STAGE(PG8_SA(1, 1), a1 + hstepA, voffA);
            PG8_WAIT_V(8); PG8_WAIT_L(0); PG8_BAR; PG8_MMA(0, 0, At, B0); PG8_MMA(0, 1, At, B1); PG8_BAR; PG8_SCHED;
            PG8_LDA(At, 0, 1); PG8_STAGE(PG8_SB(0, 0), b2, voffB); PG8_STAGE(PG8_SB(0, 1), b2 + hstepB, voffB); PG8_STAGE(PG8_SA(0, 0), a2, voffA);
            PG8_WAIT_V(8); PG8_WAIT_L(0); PG8_BAR; PG8_MMA(1, 0, At, B0); PG8_MMA(1, 1, At, B1); PG8_BAR; PG8_SCHED;
            PG8_LDB(B0, 1, 0); PG8_LDB(B1, 1, 1); PG8_SCHED; PG8_LDA(At, 1, 0); PG8_STAGE(PG8_SA(0, 1), a2 + hstepA, voffA);
            PG8_WAIT_V(8); PG8_WAIT_L(0); PG8_BAR; PG8_MMA(0, 0, At, B0); PG8_MMA(0, 1, At, B1); PG8_BAR; PG8_SCHED;
            PG8_LDA(At, 1, 1); PG8_STAGE(PG8_SB(1, 0), b3, voffB); PG8_STAGE(PG8_SB(1, 1), b3 + hstepB, voffB); PG8_STAGE(PG8_SA(1, 0), a3, voffA);
            PG8_WAIT_V(8); PG8_WAIT_L(0); PG8_BAR; PG8_MMA(1, 0, At, B0); PG8_MMA(1, 1, At, B1); PG8_BAR; PG8_SCHED;
        }
        if constexpr (ALIGN_EPI) { if (wr == 0) PG8_BAR; }
        E(acc, cur, wr, wc, fr, fq);
        if (!has_next) break;
#pragma unroll
        for (int a = 0; a < 2; ++a)
#pragma unroll
            for (int b = 0; b < 2; ++b)
#pragma unroll
                for (int m = 0; m < 4; ++m)
#pragma unroll
                    for (int n = 0; n < 2; ++n) acc[a][b][m][n] = (f32x4){0.f, 0.f, 0.f, 0.f};
        cur = nxt; cA = nA; cB = nB; ++ui;
        if constexpr (ALIGN_EPI) { if (wr == 1) PG8_BAR; }
    }
    PG8_WAIT_V(0);
    if constexpr (!ALIGN_EPI) { if (wr == 0) PG8_BAR; }
    PG8_BAR;
#undef PG8_SA
#undef PG8_SB
#undef PG8_STAGE
#undef PG8_LDA
#undef PG8_LDB
#undef PG8_MMA
#undef PG8_WAIT_V
#undef PG8_WAIT_L
#undef PG8_BAR
#undef PG8_SCHED
}

#define EPI_LOOP_BEGIN const int row0 = u.pm * BM + wr * 64 + fr; const int cl = wc * 32 + 8 * fq; \
    _Pragma("unroll") for (int ai = 0; ai < 2; ++ai) _Pragma("unroll") for (int m = 0; m < 4; ++m) { const size_t row = (size_t)(row0 + ai * HALF + m * 16);
#define EPI_LOOP_END }
__device__ __forceinline__ u32x4 pack8(const f32x4 v0, const f32x4 v1) { u32x4 w; w.x = cvt_pk_bf16(v0[0], v0[1]); w.y = cvt_pk_bf16(v0[2], v0[3]); w.z = cvt_pk_bf16(v1[0], v1[1]); w.w = cvt_pk_bf16(v1[2], v1[3]); return w; }

struct EpiPlain {
    bf16_t* O; int ldc;
    __device__ __forceinline__ void operator()(const f32x4 (&acc)[2][2][4][2], const Unit& u, int wr, int wc, int fr, int fq) const {
        EPI_LOOP_BEGIN
            bf16_t* rp = O + row * ldc + u.pn * BM + cl;
#pragma unroll
            for (int bj = 0; bj < 2; ++bj) *(u32x4*)(rp + bj * HALF) = pack8(acc[ai][bj][m][0], acc[ai][bj][m][1]);
        EPI_LOOP_END
    }
};
struct EpiP1a {
    bf16_t* iq; bf16_t* dq; float* dc; float* misc;
    __device__ __forceinline__ void operator()(const f32x4 (&acc)[2][2][4][2], const Unit& u, int wr, int wc, int fr, int fq) const {
        if (u.pn < 16) {
            bf16_t* base = (u.pn < 8) ? iq : dq; const int ct = (u.pn & 7) * BM;
            EPI_LOOP_BEGIN
                bf16_t* rp = base + row * DM + ct + cl;
#pragma unroll
                for (int bj = 0; bj < 2; ++bj) *(u32x4*)(rp + bj * HALF) = pack8(acc[ai][bj][m][0], acc[ai][bj][m][1]);
            EPI_LOOP_END
        } else {
            float* base = (u.pn == 16) ? dc : misc;
            EPI_LOOP_BEGIN
                float* rp = base + row * 256 + cl;
#pragma unroll
                for (int bj = 0; bj < 2; ++bj) { *(f32x4*)(rp + bj * HALF) = acc[ai][bj][m][0]; *(f32x4*)(rp + bj * HALF + 4) = acc[ai][bj][m][1]; }
            EPI_LOOP_END
        }
    }
};
struct EpiP1b {
    bf16_t* gqk; bf16_t* gv; bf16_t* gr; bf16_t* sg; bf16_t* sd;
    __device__ __forceinline__ void operator()(const f32x4 (&acc)[2][2][4][2], const Unit& u, int wr, int wc, int fr, int fq) const {
        const int seg = u.pn >> 3; const int ct = (u.pn & 7) * BM;
        bf16_t* base = seg == 0 ? gqk : seg == 1 ? gv : seg == 2 ? gr : seg == 3 ? sg : sd;
        const bool sig = seg >= 3;
        EPI_LOOP_BEGIN
            bf16_t* rp = base + row * DM + ct + cl;
#pragma unroll
            for (int bj = 0; bj < 2; ++bj) { f32x4 v0 = acc[ai][bj][m][0], v1 = acc[ai][bj][m][1];
                if (sig) {
#pragma unroll
                    for (int e = 0; e < 4; ++e) { v0[e] = sigmoidf_(v0[e]); v1[e] = sigmoidf_(v1[e]); } }
                *(u32x4*)(rp + bj * HALF) = pack8(v0, v1); }
        EPI_LOOP_END
    }
};
struct EpiGateMul {
    bf16_t* Gt;
    __device__ __forceinline__ void operator()(const f32x4 (&acc)[2][2][4][2], const Unit& u, int wr, int wc, int fr, int fq) const {
        EPI_LOOP_BEGIN
            bf16_t* rp = Gt + row * DM + u.pn * BM + cl;
#pragma unroll
            for (int bj = 0; bj < 2; ++bj) { const u32x4 gg = *(const u32x4*)(rp + bj * HALF); f32x4 v0 = acc[ai][bj][m][0], v1 = acc[ai][bj][m][1];
                v0[0] *= bf_lo(gg.x); v0[1] *= bf_hi(gg.x); v0[2] *= bf_lo(gg.y); v0[3] *= bf_hi(gg.y); v1[0] *= bf_lo(gg.z); v1[1] *= bf_hi(gg.z); v1[2] *= bf_lo(gg.w); v1[3] *= bf_hi(gg.w);
                *(u32x4*)(rp + bj * HALF) = pack8(v0, v1); }
        EPI_LOOP_END
    }
};
struct EpiMerge {
    const bf16_t* SG; const bf16_t* T; bf16_t* O;
    __device__ __forceinline__ void operator()(const f32x4 (&acc)[2][2][4][2], const Unit& u, int wr, int wc, int fr, int fq) const {
        EPI_LOOP_BEGIN
            const size_t o = row * DM + u.pn * BM + cl;
#pragma unroll
            for (int bj = 0; bj < 2; ++bj) { const u32x4 gg = *(const u32x4*)(SG + o + bj * HALF); const u32x4 tt = *(const u32x4*)(T + o + bj * HALF); f32x4 v0 = acc[ai][bj][m][0], v1 = acc[ai][bj][m][1];
                v0[0] = v0[0] * bf_lo(gg.x) + bf_lo(tt.x); v0[1] = v0[1] * bf_hi(gg.x) + bf_hi(tt.x); v0[2] = v0[2] * bf_lo(gg.y) + bf_lo(tt.y); v0[3] = v0[3] * bf_hi(gg.y) + bf_hi(tt.y);
                v1[0] = v1[0] * bf_lo(gg.z) + bf_lo(tt.z); v1[1] = v1[1] * bf_hi(gg.z) + bf_hi(tt.z); v1[2] = v1[2] * bf_lo(gg.w) + bf_lo(tt.w); v1[3] = v1[3] * bf_hi(gg.w) + bf_hi(tt.w);
                *(u32x4*)(O + o + bj * HALF) = pack8(v0, v1); }
        EPI_LOOP_END
    }
};
struct EpiSwiglu {
    bf16_t* H;
    __device__ __forceinline__ void operator()(const f32x4 (&acc)[2][2][4][2], const Unit& u, int wr, int wc, int fr, int fq) const {
        EPI_LOOP_BEGIN
            f32x4 v0, v1;
#pragma unroll
            for (int e = 0; e < 4; ++e) { const float g0 = acc[ai][0][m][0][e], g1 = acc[ai][0][m][1][e];
                v0[e] = g0 * sigmoidf_(g0) * acc[ai][1][m][0][e]; v1[e] = g1 * sigmoidf_(g1) * acc[ai][1][m][1][e]; }
            *(u32x4*)(H + row * DFF + u.pn * HALF + cl) = pack8(v0, v1);
        EPI_LOOP_END
    }
};
}

#define XB_TMO      128
#define XB_XCNT(j)  (256  + 64 * (j))
#define XB_XSUB(j)  (1280 + 64 * (j))
#define XB_XGEN(j)  (2304 + 64 * (j))
#define XB_TOP      3328
#define XB_TOPGEN   3392
#define XCD_BAR_WORDS 3456
#define XB_SPIN_CAP (1u << 22)
__device__ __forceinline__ unsigned xb_ld(unsigned* p)              { return __hip_atomic_load(p, __ATOMIC_RELAXED, __HIP_MEMORY_SCOPE_AGENT); }
__device__ __forceinline__ unsigned xb_add(unsigned* p, unsigned v) { return __hip_atomic_fetch_add(p, v, __ATOMIC_RELAXED, __HIP_MEMORY_SCOPE_AGENT); }
__device__ __forceinline__ unsigned xb_xcc_id() { return (unsigned)__builtin_amdgcn_s_getreg((3 << 11) | 20) & 0xFu; }
#define XB_SPIN(cond, bar) do { unsigned _sp = 0; while (cond) { __builtin_amdgcn_s_sleep(1); \
    if ((++_sp & 255u) == 0u) { if (xb_ld(&(bar)[XB_TMO])) break; if (_sp > XB_SPIN_CAP) { atomicAdd(&(bar)[XB_TMO], 1u); break; } } } } while (0)
struct XcdBarrier { unsigned* bar; unsigned x; volatile LAS unsigned* st; int wave; };
__device__ __forceinline__ bool xb_thread0(int wave) { return wave == 0 && fresh_lane() == 0; }
__device__ __forceinline__ XcdBarrier xcd_barrier_post(unsigned* bar, volatile LAS unsigned* st, int wave) {
    XcdBarrier b; b.bar = bar; b.x = xb_xcc_id(); b.st = st; b.wave = wave;
    if (xb_thread0(b.wave)) (void)xb_add(&bar[XB_XCNT(b.x)], 1u);
    return b;
}
__device__ __forceinline__ void xcd_barrier_complete(unsigned* bar, unsigned x, unsigned& nloc, unsigned& nx) {
    const unsigned G = gridDim.x * gridDim.y * gridDim.z;
    unsigned sum, cnt, mine, sp = 0u;
    for (;;) {
        sum = 0u; cnt = 0u; mine = 0u;
#pragma unroll
        for (unsigned j = 0; j < 16; ++j) { const unsigned c = xb_ld(&bar[XB_XCNT(j)]); sum += c; cnt += (c > 0u) ? 1u : 0u; mine = (j == x) ? c : mine; }
        if (sum == G) break;
        __builtin_amdgcn_s_sleep(1);
        if ((++sp & 255u) == 0u) { if (xb_ld(&bar[XB_TMO])) break; if (sp > XB_SPIN_CAP) { atomicAdd(&bar[XB_TMO], 1u); break; } }
    }
    nloc = mine > 0u ? mine : 1u; nx = cnt > 0u ? cnt : 1u;
}
#ifndef BAR_SCOPE
#define BAR_SCOPE "agent"
#endif
__device__ __forceinline__ void xcd_barrier(const XcdBarrier& b) {
    asm volatile("s_waitcnt vmcnt(0)" ::: "memory");
    __syncthreads();
    if (xb_thread0(b.wave)) {
        unsigned* bar = b.bar;
        __builtin_amdgcn_s_waitcnt(0);
        unsigned nloc = b.st[0], nx = b.st[1];
        if (nloc == 0u) { xcd_barrier_complete(bar, b.x, nloc, nx); b.st[0] = nloc; b.st[1] = nx; }
        const unsigned old = xb_add(&bar[XB_XSUB(b.x)], 1u);
        const unsigned gen = old / nloc;
        if (old + 1u == (gen + 1u) * nloc) {
            __builtin_amdgcn_fence(__ATOMIC_RELEASE, BAR_SCOPE);
            asm volatile("s_waitcnt vmcnt(0)" ::: "memory");
            const unsigned og = xb_add(&bar[XB_TOP], 1u);
            const unsigned tg = og / nx;
            if (og + 1u == (tg + 1u) * nx) xb_add(&bar[XB_TOPGEN], 1u);
            else XB_SPIN(xb_ld(&bar[XB_TOPGEN]) == tg, bar);
            __builtin_amdgcn_fence(__ATOMIC_ACQUIRE, BAR_SCOPE);
            xb_add(&bar[XB_XGEN(b.x)], 1u);
            asm volatile("s_waitcnt vmcnt(0)" ::: "memory");
        } else {
            XB_SPIN(xb_ld(&bar[XB_XGEN(b.x)]) == gen, bar);
            __builtin_amdgcn_fence(__ATOMIC_ACQUIRE, BAR_SCOPE);
            asm volatile("s_waitcnt vmcnt(0)" ::: "memory");
        }
    }
    __syncthreads();
}

struct Params { const float* in[28]; float* out; unsigned char* ws; };
#define KARG_IN(i) (*(const float* const volatile __attribute__((address_space(4)))*)((const __attribute__((address_space(4))) char*)__builtin_amdgcn_kernarg_segment_ptr() + 8 * (i)))

enum { I_X = 0, I_MEM, I_WIN, I_WA2, I_BA, I_GONORM, I_WUK, I_WUV, I_LATNORM, I_IKW, I_IKB, I_RELB, I_WGB, I_WDB, I_WMIX, I_MIXPRE, I_MIXPOST, I_XAPRE, I_XAPOST, I_XAMEM,
       I_WXQ, I_WXKV, I_WXO, I_FFPRE, I_FFPOST, I_WFG, I_WFU, I_WFD };

__device__ __forceinline__ void conv_item(const float* W, int ldw, int c0, int ncols, bf16* dst, int dk, int koff, int r0, LAS float* scr, int item, int lane) {
    const int nblk = (ncols + 63) >> 6, kb = item / nblk, nb = item - kb * nblk, k0 = 64 * kb, n0 = 64 * nb, nv = ncols - n0;
    const int c4 = lane & 15, r = lane >> 4;
    LAS unsigned char* t = (LAS unsigned char*)scr;
    f32x4 v[16];
    const float* src = W + (size_t)(k0 + 16 * r) * ldw + c0 + n0 + 4 * c4;
    if (4 * c4 < nv) {
#pragma unroll
        for (int i = 0; i < 16; ++i) v[i] = *(const f32x4*)(src + (size_t)i * ldw);
    } else {
#pragma unroll
        for (int i = 0; i < 16; ++i) v[i] = (f32x4){0.f, 0.f, 0.f, 0.f};
    }
#pragma unroll
    for (int e = 0; e < 4; ++e) {
        u32x4 a, b;
        a.x = cvt_pk_bf16(v[0][e], v[1][e]); a.y = cvt_pk_bf16(v[2][e], v[3][e]); a.z = cvt_pk_bf16(v[4][e], v[5][e]); a.w = cvt_pk_bf16(v[6][e], v[7][e]);
        b.x = cvt_pk_bf16(v[8][e], v[9][e]); b.y = cvt_pk_bf16(v[10][e], v[11][e]); b.z = cvt_pk_bf16(v[12][e], v[13][e]); b.w = cvt_pk_bf16(v[14][e], v[15][e]);
        *(LAS u32x4*)(t + (4 * c4 + e) * 144 + r * 32) = a; *(LAS u32x4*)(t + (4 * c4 + e) * 144 + r * 32 + 16) = b;
    }
    LDS_WAIT();
    const int ch = lane & 7;
#pragma unroll
    for (int j = 0; j < 8; ++j) { const int n = (lane >> 3) + 8 * j; const u32x4 o = *(const LAS u32x4*)(t + n * 144 + ch * 16);
        if (n < nv) *(GAS u32x4*)(dst + (size_t)(r0 + n0 + n) * dk + koff + k0 + 8 * ch) = o; }
    LDS_WAIT();
}
__device__ __forceinline__ void conv_seg(const float* W, int ldw, int K, int c0, int ncols, bf16* dst, int dk, int koff, int r0, LAS float* scr, int gw, int NGW, int lane) {
    const int items = (K >> 6) * ((ncols + 63) >> 6);
    for (int it = gw; it < items; it += NGW) conv_item(W, ldw, c0, ncols, dst, dk, koff, r0, scr, it, lane);
}

__device__ __forceinline__ void rms_row_to_bf16(const float* xrow, const float* gain, bf16* orow, int lane) {
    const f32x4* xr = (const f32x4*)xrow + lane; const f32x4* gr = (const f32x4*)gain + lane;
    f32x4 v[8]; float s = 0.f;
#pragma unroll
    for (int j = 0; j < 8; ++j) { v[j] = xr[64 * j]; s += (v[j].x * v[j].x + v[j].y * v[j].y) + (v[j].z * v[j].z + v[j].w * v[j].w); }
    const float rstd = rsqrtf(wave_sum(s) * (1.f / DM) + EPS);
    u32x2* o8 = (u32x2*)orow + lane;
#pragma unroll
    for (int j = 0; j < 8; ++j) { const f32x4 g = gr[64 * j]; u32x2 w; w.x = cvt_pk_bf16(v[j].x * rstd * g.x, v[j].y * rstd * g.y); w.y = cvt_pk_bf16(v[j].z * rstd * g.z, v[j].w * rstd * g.w); o8[64 * j] = w; }
}
__device__ __forceinline__ void resid_row(const float* hold, const bf16* yrow, const float* gpost, float* hout, const float* gpre, bf16* urow, int lane) {
    const u32x2* yr = (const u32x2*)yrow + lane; const f32x4* hr = (const f32x4*)hold + lane; const f32x4* gp = (const f32x4*)gpost + lane;
    f32x4 y[8]; float s = 0.f;
#pragma unroll
    for (int j = 0; j < 8; ++j) { const u32x2 w = yr[64 * j]; y[j] = (f32x4){bf_lo(w.x), bf_hi(w.x), bf_lo(w.y), bf_hi(w.y)}; s += (y[j].x * y[j].x + y[j].y * y[j].y) + (y[j].z * y[j].z + y[j].w * y[j].w); }
    const float rstd = rsqrtf(wave_sum(s) * (1.f / DM) + EPS);
    float s2 = 0.f;
#pragma unroll
    for (int j = 0; j < 8; ++j) { const f32x4 h = hr[64 * j]; const f32x4 g = gp[64 * j]; y[j] = h + y[j] * rstd * g; s2 += (y[j].x * y[j].x + y[j].y * y[j].y) + (y[j].z * y[j].z + y[j].w * y[j].w); }
    f32x4* ho = (f32x4*)hout + lane;
#pragma unroll
    for (int j = 0; j < 8; ++j) ho[64 * j] = y[j];
    if (urow) {
        const float r2 = rsqrtf(wave_sum(s2) * (1.f / DM) + EPS); const f32x4* g2 = (const f32x4*)gpre + lane; u32x2* o8 = (u32x2*)urow + lane;
#pragma unroll
        for (int j = 0; j < 8; ++j) { const f32x4 g = g2[64 * j]; u32x2 w; w.x = cvt_pk_bf16(y[j].x * r2 * g.x, y[j].y * r2 * g.y); w.y = cvt_pk_bf16(y[j].z * r2 * g.z, y[j].w * r2 * g.w); o8[64 * j] = w; }
    }
}

struct Frame {
    LAS unsigned char* lds;
    int tid, lane, wave, bid, G;
};

__device__ __forceinline__ void p0_prologue(const Params& p, const Frame& F) {
    LAS float* scr = (LAS float*)(F.lds + F.wave * 16384);
    const int gw = F.bid * NWAVES + F.wave, NGW = F.G * NWAVES, lane = F.lane;
    unsigned char* ws = p.ws;
    const float* win = KARG_IN(I_WIN);
    bf16* w1a = (bf16*)(ws + WS_W1A); bf16* w1b = (bf16*)(ws + WS_W1B);
    conv_seg(win, INCOLS, DM, 8464, 2048, w1a, DM, 0, 0, scr, gw, NGW, lane);
    conv_seg(win, INCOLS, DM, 6160, 2048, w1a, DM, 0, 2048, scr, gw, NGW, lane);
    conv_seg(win, INCOLS, DM, 8208, 256, w1a, DM, 0, 4096, scr, gw, NGW, lane);
    conv_seg(win, INCOLS, DM, 10512, 128, w1a, DM, 0, 4352, scr, gw, NGW, lane);
    conv_seg(win, INCOLS, DM, 10640, 16, w1a, DM, 0, 4480, scr, gw, NGW, lane);
    conv_seg(win, INCOLS, DM, 6144, 16, w1a, DM, 0, 4496, scr, gw, NGW, lane);
    { u32x4* z = (u32x4*)(w1a + (size_t)4512 * DM); const int nz = 96 * DM * 2 / 16; for (int i = gw * 64 + lane; i < nz; i += NGW * 64) z[i] = (u32x4){0u, 0u, 0u, 0u}; }
    conv_seg(win, INCOLS, DM, 0, 6144, w1b, DM, 0, 0, scr, gw, NGW, lane);
    conv_seg(win, INCOLS, DM, 10656, 4096, w1b, DM, 0, 6144, scr, gw, NGW, lane);
    { bf16* d = (bf16*)(ws + WS_BTUK); const float* s = KARG_IN(I_WUK);
      for (int i = gw * 64 + lane; i < 4096 * 256; i += NGW * 64) { const int row = i >> 8, k = i & 255, h = row >> 8, r = row & 255;
          const float v = ((k >> 7) == (h & 1)) ? s[((size_t)h * 128 + (k & 127)) * 256 + r] : 0.f; d[i] = (bf16)(cvt_pk_bf16(v, 0.f) & 0xffffu); } }
    { bf16* d = (bf16*)(ws + WS_BTUV); const float* s = KARG_IN(I_WUV);
      for (int i = gw * 64 + lane; i < 2048 * 512; i += NGW * 64) { const int row = i >> 9, k = i & 511, hp = row >> 8, j = (row >> 7) & 1, v = row & 127;
          const float x = ((k >> 8) == j) ? s[((size_t)(2 * hp + j) * 256 + (k & 255)) * 128 + v] : 0.f; d[i] = (bf16)(cvt_pk_bf16(x, 0.f) & 0xffffu); } }
    conv_seg(KARG_IN(I_WXKV), 2 * DM, DM, 0, 2 * DM, (bf16*)(ws + WS_WXKV0), DM, 0, 0, scr, gw, NGW, lane);
    { bf16* u0 = (bf16*)(ws + WS_U0); for (int m = gw; m < M; m += NGW) rms_row_to_bf16(KARG_IN(I_X) + (size_t)m * DM, KARG_IN(I_MIXPRE), u0 + (size_t)m * DM, lane); }
    { bf16* mn = (bf16*)(ws + WS_MEMN); for (int m = gw; m < NB * NMEM; m += NGW) rms_row_to_bf16(KARG_IN(I_MEM) + (size_t)m * DM, KARG_IN(I_XAMEM), mn + (size_t)m * DM, lane); }
}

__device__ __forceinline__ void p2_norms(const Params& p, const Frame& F) {
    const int gw = F.bid * NWAVES + F.wave, NGW = F.G * NWAVES, lane = F.lane;
    const float* dc = (const float*)(p.ws + WS_DCRAW); const float* misc = (const float*)(p.ws + WS_MISC);
    bf16* clat = (bf16*)(p.ws + WS_CLAT); bf16* kidx = (bf16*)(p.ws + WS_KIDX);
    const f32x4 gl = ((const f32x4*)KARG_IN(I_LATNORM))[lane];
    const f32x2 kw = ((const f32x2*)KARG_IN(I_IKW))[lane], kb = ((const f32x2*)KARG_IN(I_IKB))[lane];
    for (int m = gw; m < M; m += NGW) {
        const f32x4 v = ((const f32x4*)(dc + (size_t)m * 256))[lane];
        const float ss = wave_sum((v.x * v.x + v.y * v.y) + (v.z * v.z + v.w * v.w));
        const float rstd = rsqrtf(ss * (1.f / 256.f) + EPS);
        u32x2 w; w.x = cvt_pk_bf16(v.x * rstd * gl.x, v.y * rstd * gl.y); w.y = cvt_pk_bf16(v.z * rstd * gl.z, v.w * rstd * gl.w);
        ((u32x2*)(clat + (size_t)m * 256))[lane] = w;
        const f32x2 a = ((const f32x2*)(misc + (size_t)m * 256))[lane];
        const float mu = wave_sum(a.x + a.y) * (1.f / 128.f);
        const float dx = a.x - mu, dy = a.y - mu;
        const float var = wave_sum(dx * dx + dy * dy) * (1.f / 128.f);
        const float r2 = rsqrtf(var + EPS);
        ((unsigned*)(kidx + (size_t)m * 128))[lane] = cvt_pk_bf16(dx * r2 * kw.x + kb.x, dy * r2 * kw.y + kb.y);
    }
}

constexpr int IDX_KROW = 272;
constexpr int IDX_KBUF = 64 * IDX_KROW;
__device__ __forceinline__ int wave_incl_scan(int v) {
    v += __builtin_amdgcn_update_dpp(0, v, 0x111, 0xf, 0xf, true);
    v += __builtin_amdgcn_update_dpp(0, v, 0x112, 0xf, 0xf, true);
    v += __builtin_amdgcn_update_dpp(0, v, 0x114, 0xf, 0xf, true);
    v += __builtin_amdgcn_update_dpp(0, v, 0x118, 0xf, 0xf, true);
    v += __builtin_amdgcn_update_dpp(0, v, 0x142, 0xa, 0xf, false);
    v += __builtin_amdgcn_update_dpp(0, v, 0x143, 0xc, 0xf, false);
    return v;
}
__device__ __forceinline__ void idx_select_query(const unsigned* rowp, int L, u16* outp, int lane) {
    unsigned kp[64];
    int lane2 = (lane >> 5) * 64 + (lane & 31); asm volatile("" : "+v"(lane2));
    const int tbase = (lane >> 5) * 64;
    const int nblk = (L + 1023) >> 10;
#pragma unroll
    for (int blk = 0; blk < 8; ++blk) {
        if (blk < nblk) {
#pragma unroll
            for (int r = blk * 8; r < blk * 8 + 8; ++r) {
                const unsigned pb = rowp[r * 64 + lane];
                const unsigned mneg = ((pb >> 15) & 0x00010001u) * 0xFFFFu;
                const unsigned k = pb ^ (mneg | 0x80008000u);
                kp[r] = (tbase < L - r * 128) ? k : 0u;
            }
        } else {
#pragma unroll
            for (int r = blk * 8; r < blk * 8 + 8; ++r) kp[r] = 0u;
        }
    }
    unsigned T = 0u;
    for (int bit = 15; bit >= 0; --bit) {
        const unsigned c16v = T | (1u << bit); const unsigned cand = c16v << 16; const u16 c16 = (u16)c16v; int cnt = 0;
#pragma unroll
        for (int blk = 0; blk < 8; ++blk) {
            if (blk < nblk) {
#pragma unroll
                for (int r = blk * 8; r < blk * 8 + 8; ++r) {
                    cnt += __popcll(__ballot(kp[r] >= cand)); cnt += __popcll(__ballot((u16)kp[r] >= c16));
                    if ((r & 1) == 1) __builtin_amdgcn_sched_barrier(0);
                }
            }
        }
        if (cnt >= TOPK) T = c16v;
    }
    int ngt = 0, neq = 0;
#pragma unroll
    for (int blk = 0; blk < 8; ++blk) {
        if (blk < nblk) {
#pragma unroll
            for (int r = blk * 8; r < blk * 8 + 8; ++r) { const unsigned hi = kp[r] >> 16, lo = kp[r] & 0xFFFFu;
                ngt += (hi > T) ? 1 : 0; ngt += (lo > T) ? 1 : 0; neq += (hi == T) ? 1 : 0; neq += (lo == T) ? 1 : 0; }
        }
    }
    const int sg = wave_incl_scan(ngt), se = wave_incl_scan(neq);
    const int tot_gt = __builtin_amdgcn_readlane(sg, 63);
    const int need = TOPK - tot_gt;
    const int pe = se - neq;
    int quota = need - pe; quota = quota < 0 ? 0 : (quota > neq ? neq : quota);
    int og = sg - ngt;
    int oe = tot_gt + (pe < need ? pe : need);
#pragma unroll
    for (int blk = 0; blk < 8; ++blk) {
        if (blk < nblk) {
#pragma unroll
            for (int r = blk * 8; r < blk * 8 + 8; ++r) {
#pragma unroll
                for (int hlf = 0; hlf < 2; ++hlf) {
                    const unsigned kv = hlf ? (kp[r] >> 16) : (kp[r] & 0xFFFFu);
                    const u16 id = (u16)(lane2 + (r * 128 + hlf * 32));
                    if (kv > T) { outp[og] = id; ++og; }
                    else if (kv == T && quota > 0) { outp[oe] = id; ++oe; --quota; }
                }
            }
        }
    }
}

template <int NSEL> __device__ __forceinline__ void p3_indexer(const Params& p, const Frame& F) {
    const int lane = F.lane, wave = F.wave, tid = F.tid;
    const bf16* iq = (const bf16*)(p.ws + WS_IQ); const bf16* kidx = (const bf16*)(p.ws + WS_KIDX); const float* misc = (const float*)(p.ws + WS_MISC);
    u16* idxo = (u16*)(p.ws + WS_IDX);
    f16* scr = (f16*)(p.ws + WS_SCR) + (size_t)F.bid * 32 * SEQ;
    const float wscale = 0.25f * 0.08838834764831845f;
    for (int uu = F.bid; uu < 512; uu += F.G) {
        const int b = uu & 1; int hc = (uu & 255) >> 1; if (uu >> 8) hc = 255 - hc;
        const int c = hc >> 1, L = (c + 1) * CHUNK, t0 = hc * 32; const size_t mb = (size_t)b * SEQ;
        if (L <= TOPK) {
#pragma unroll
            for (int q = 0; q < 4; ++q) { u16* o = idxo + (mb + t0 + 4 * wave + q) * TOPK;
#pragma unroll
                for (int j = 0; j < 4; ++j) { const int i = lane + 64 * j; o[i] = (u16)(i < L ? i : 0); } }
            continue;
        }
        bf16x8 afr[2][8]; float wq[2][16];
#pragma unroll
        for (int rt = 0; rt < 2; ++rt) {
            const int r = lane & 31, q = (r >> 2) & 1, head = 4 * (r >> 3) + (r & 3);
            const bf16* src = iq + (mb + t0 + 4 * wave + 2 * rt + q) * DM + head * IDIM + 8 * (lane >> 5);
#pragma unroll
            for (int ks = 0; ks < 8; ++ks) afr[rt][ks] = *(const bf16x8*)(src + ks * 16);
            const float* wsrc = misc + (mb + t0 + 4 * wave + 2 * rt + (lane >> 5)) * 256 + 128;
#pragma unroll
            for (int i4 = 0; i4 < 4; ++i4) { const f32x4 w4 = *(const f32x4*)(wsrc + 4 * i4); wq[rt][4 * i4 + 0] = w4.x * wscale; wq[rt][4 * i4 + 1] = w4.y * wscale; wq[rt][4 * i4 + 2] = w4.z * wscale; wq[rt][4 * i4 + 3] = w4.w * wscale; }
        }
        const int nkt = L / 64;
        u32x4 st[2];
#pragma unroll
        for (int i = 0; i < 2; ++i) { const int e = tid + 512 * i, key = e >> 4, ch = e & 15; st[i] = *(const u32x4*)(kidx + (mb + key) * IDIM + ch * 8); }
#pragma unroll
        for (int i = 0; i < 2; ++i) { const int e = tid + 512 * i, key = e >> 4, ch = e & 15; *(LAS u32x4*)(F.lds + key * IDX_KROW + ch * 16) = st[i]; }
        __syncthreads();
        for (int kt = 0; kt < nkt; ++kt) {
            LAS unsigned char* buf = F.lds + (kt & 1) * IDX_KBUF;
            if (kt + 1 < nkt) {
#pragma unroll
                for (int i = 0; i < 2; ++i) { const int e = tid + 512 * i, key = e >> 4, ch = e & 15; st[i] = *(const u32x4*)(kidx + (mb + (kt + 1) * 64 + key) * IDIM + ch * 8); }
            }
            {
                bf16x8 bf0[8], bf1[8];
#pragma unroll
                for (int ks = 0; ks < 8; ++ks) bf0[ks] = *(const LAS bf16x8*)(buf + (lane & 31) * IDX_KROW + (ks * 16 + 8 * (lane >> 5)) * 2);
#pragma unroll
                for (int ks = 0; ks < 8; ++ks) bf1[ks] = *(const LAS bf16x8*)(buf + (32 + (lane & 31)) * IDX_KROW + (ks * 16 + 8 * (lane >> 5)) * 2);
                unsigned* srow = (unsigned*)scr + (size_t)(4 * wave + (lane >> 5)) * (SEQ / 2) + kt * 32 + (lane & 31);
                float sprev[2];
#define IDX_MMA(ACC, RT, BF) do { _Pragma("unroll") for (int i = 0; i < 16; ++i) ACC[i] = 0.f; \
                _Pragma("unroll") for (int ks = 0; ks < 8; ++ks) ACC = __builtin_amdgcn_mfma_f32_32x32x16_bf16(afr[RT][ks], BF[ks], ACC, 0, 0, 0); } while (0)
#define IDX_EPI(ACC, RT, SUB) do { float s_ = 0.f; _Pragma("unroll") for (int i = 0; i < 16; ++i) { const float af_ = ACC[i]; const int ai_ = __builtin_bit_cast(int, af_); s_ += wq[RT][i] * __builtin_bit_cast(float, ai_ > 0 ? ai_ : 0); }   \
                if ((SUB) == 0) sprev[RT] = s_; else { const f16 lo_ = (f16)sprev[RT], hi_ = (f16)s_; \
                    srow[(size_t)(2 * (RT)) * (SEQ / 2)] = (unsigned)__builtin_bit_cast(unsigned short, lo_) | ((unsigned)__builtin_bit_cast(unsigned short, hi_) << 16); } } while (0)
#define IDX_ILV() do { _Pragma("unroll") for (int k_ = 0; k_ < 8; ++k_) { __builtin_amdgcn_sched_group_barrier(0x008, 1, 0); __builtin_amdgcn_sched_group_barrier(0x002, 5, 0); } } while (0)
                f32x16 accA, accB;
                IDX_MMA(accA, 0, bf0);
                IDX_MMA(accB, 1, bf0); IDX_EPI(accA, 0, 0); IDX_ILV();
                IDX_MMA(accA, 0, bf1); IDX_EPI(accB, 1, 0); IDX_ILV();
                IDX_MMA(accB, 1, bf1); IDX_EPI(accA, 0, 1); IDX_ILV();
                IDX_EPI(accB, 1, 1);
#undef IDX_MMA
#undef IDX_EPI
#undef IDX_ILV
            }
            if (kt + 1 < nkt) {
                LAS unsigned char* nb = F.lds + ((kt + 1) & 1) * IDX_KBUF;
#pragma unroll
                for (int i = 0; i < 2; ++i) { const int e = tid + 512 * i, key = e >> 4, ch = e & 15; *(LAS u32x4*)(nb + key * IDX_KROW + ch * 16) = st[i]; }
            }
            __syncthreads();
        }
        VM_WAIT();
        __builtin_amdgcn_fence(__ATOMIC_ACQUIRE, "agent");
        VM_WAIT();
#pragma unroll 1
        for (int q = 0; q < 4 * NSEL; ++q)
            idx_select_query((const unsigned*)(scr + (size_t)(4 * wave + (q & 3)) * SEQ), L, idxo + (mb + t0 + 4 * wave + (q & 3)) * TOPK, lane);
        VM_WAIT();
    }
}

constexpr int DSA_ROW = 544, DSA_WBUF = 16 * DSA_ROW, DSA_WREG = 2 * DSA_WBUF;
constexpr int DSA_IDX_OFF = 8 * DSA_WREG, DSA_BKT_OFF = DSA_IDX_OFF + 8 * 512, DSA_BIAS_OFF = DSA_BKT_OFF + 8 * 256;
static_assert(DSA_BIAS_OFF + 2048 <= MISC_OFF, "dsa lds");
__device__ __forceinline__ unsigned t5_bucket(int rel) {
    const unsigned ret = rel > 0 ? 16u : 0u; const int n = rel < 0 ? -rel : rel; unsigned v;
    if (n < 8) v = (unsigned)n; else { const unsigned n2 = (unsigned)n * (unsigned)n; v = 2u + (31u - (unsigned)__clz((int)n2)); if (v > 15u) v = 15u; }
    return ret + v;
}
__device__ __forceinline__ void p4_dsa(const Params& p, const Frame& F) {
    const int lane = F.lane, wave = F.wave, g = lane >> 4, l15 = lane & 15;
    const u16* idx = (const u16*)(p.ws + WS_IDX); const bf16* clat = (const bf16*)(p.ws + WS_CLAT);
    const bf16* qlat = (const bf16*)p.out; bf16* olat = (bf16*)p.out;
    LAS float* biasT = (LAS float*)(F.lds + DSA_BIAS_OFF);
    biasT[F.tid] = KARG_IN(I_RELB)[F.tid];
    __syncthreads();
    LAS unsigned char* wb = F.lds + wave * DSA_WREG;
    LAS u16* widx = (LAS u16*)(F.lds + DSA_IDX_OFF + wave * 512);
    LAS unsigned* wbkt = (LAS unsigned*)(F.lds + DSA_BKT_OFF + wave * 256);
    const float SC = 0.08838834764831845f;
    for (int uu = F.bid; uu < 512; uu += F.G)
    for (int qq = 0; qq < 4; ++qq) {
        const int ub = uu & 1; int uhc = (uu & 255) >> 1; if (uu >> 8) uhc = 255 - uhc;
        const int mq = ub * SEQ + uhc * 32 + 4 * wave + qq;
        const int tpos = mq & (SEQ - 1), b = mq >> 13, c = tpos >> 6;
        const int n = ((c + 1) * CHUNK < TOPK) ? (c + 1) * CHUNK : TOPK, ntile = n >> 4;
        const u32x2 iv = *(const u32x2*)(idx + (size_t)mq * TOPK + 4 * lane);
        *(LAS u32x2*)(widx + 4 * lane) = iv;
        wbkt[lane] = t5_bucket((int)(iv.x & 0xffffu) - tpos) | (t5_bucket((int)(iv.x >> 16) - tpos) << 8) | (t5_bucket((int)(iv.y & 0xffffu) - tpos) << 16) | (t5_bucket((int)(iv.y >> 16) - tpos) << 24);
        bf16x8 bq[8];
        { const bf16* qs = qlat + (size_t)mq * 4096 + l15 * 256 + 8 * g;
#pragma unroll
          for (int kk = 0; kk < 8; ++kk) bq[kk] = *(const bf16x8*)(qs + 32 * kk); }
        LDS_WAIT();
        const bf16* cb = clat + (size_t)b * SEQ * DLAT + (lane & 31) * 8;
        u32x4 grA[8], grB[8];
#define DSA_GATHER(T_, GR_) do { _Pragma("unroll") for (int i = 0; i < 8; ++i) { const unsigned key = widx[16 * (T_) + 2 * i + (lane >> 5)]; GR_[i] = *(const u32x4*)(cb + (size_t)key * DLAT); } } while (0)
#define DSA_PUT(BUF_, GR_) do { _Pragma("unroll") for (int i = 0; i < 8; ++i) *(LAS u32x4*)((BUF_) + (2 * i + (lane >> 5)) * DSA_ROW + (lane & 31) * 16) = GR_[i]; } while (0)
#define DSA_TILE(T_, BUF_) do { LAS unsigned char* buf = (BUF_); \
            f32x4 s = (f32x4){0.f, 0.f, 0.f, 0.f}; \
            _Pragma("unroll") for (int kk = 0; kk < 8; ++kk) { const bf16x8 a = *(const LAS bf16x8*)(buf + l15 * DSA_ROW + (32 * kk + 8 * g) * 2); s = __builtin_amdgcn_mfma_f32_16x16x32_bf16(a, bq[kk], s, 0, 0, 0); } \
            const unsigned bk = wbkt[4 * (T_) + g]; \
            float x[4]; \
            _Pragma("unroll") for (int r = 0; r < 4; ++r) x[r] = s[r] * SC + biasT[((bk >> (8 * r)) & 0xffu) * 16 + l15]; \
            float tm = fmaxf(fmaxf(x[0], x[1]), fmaxf(x[2], x[3])); \
            tm = x16_max(tm); tm = x32_max(tm); \
            if (__any(tm > mrun)) { const float mn = fmaxf(mrun, tm), al = __expf(mrun - mn); \
                _Pragma("unroll") for (int mt = 0; mt < 16; ++mt) O[mt] = O[mt] * al; \
                lsum *= al; mrun = mn; } \
            float pr[4]; \
            _Pragma("unroll") for (int r = 0; r < 4; ++r) { pr[r] = __expf(x[r] - mrun); lsum += pr[r]; } \
            u32x2 pw; pw.x = cvt_pk_bf16(pr[0], pr[1]); pw.y = cvt_pk_bf16(pr[2], pr[3]); \
            const bf16x4 pf = __builtin_bit_cast(bf16x4, pw); \
            const LAS unsigned char* trb = buf + (4 * g + (l15 >> 2)) * DSA_ROW + (4 * (lane & 3)) * 2; \
            _Pragma("unroll") for (int mt = 0; mt < 16; ++mt) { \
                const bf16x4 a4 = __builtin_bit_cast(bf16x4, __builtin_amdgcn_ds_read_tr16_b64_v4i16((LAS v4i16_t*)(trb + mt * 32))); \
                O[mt] = __builtin_amdgcn_mfma_f32_16x16x16bf16_1k(a4, pf, O[mt], 0, 0, 0); } } while (0)
        DSA_GATHER(0, grA);
        DSA_GATHER(1, grB);
        DSA_PUT(wb, grA);
        f32x4 O[16];
#pragma unroll
        for (int mt = 0; mt < 16; ++mt) O[mt] = (f32x4){0.f, 0.f, 0.f, 0.f};
        float mrun = -INFINITY, lsum = 0.f;
        for (int T = 0; T < ntile; T += 2) {
            if (T + 2 < ntile) DSA_GATHER(T + 2, grA);
            asm volatile("" ::: "memory");
            DSA_TILE(T, wb);
            asm volatile("" ::: "memory");
            DSA_PUT(wb + DSA_WBUF, grB);
            if (T + 3 < ntile) DSA_GATHER(T + 3, grB);
            asm volatile("" ::: "memory");
            DSA_TILE(T + 1, wb + DSA_WBUF);
            asm volatile("" ::: "memory");
            if (T + 2 < ntile) DSA_PUT(wb, grA);
        }
#undef DSA_GATHER
#undef DSA_PUT
#undef DSA_TILE
        lsum = x16_sum(lsum); lsum = x32_sum(lsum);
        const float inv = __frcp_rn(lsum);
        bf16* od = olat + (size_t)mq * 4096 + l15 * 256 + 4 * g;
#pragma unroll
        for (int mt = 0; mt < 16; ++mt) { u32x2 w; w.x = cvt_pk_bf16(O[mt][0] * inv, O[mt][1] * inv); w.y = cvt_pk_bf16(O[mt][2] * inv, O[mt][3] * inv); *(u32x2*)(od + 16 * mt) = w; }
        LDS_WAIT();
    }
}

constexpr int G1_ROW = 528, G1_ARR = 64 * G1_ROW, G1_GA = 4 * G1_ARR, G1_TOT = G1_GA + 4096, G1_VROW = 1040;
static_assert(G1_TOT + 2048 <= MISC_OFF && 64 * G1_VROW <= G1_GA, "g1 lds");
__device__ __forceinline__ void p6_gla1(const Params& p, const Frame& F) {
    const int tid = F.tid, lane = F.lane, wave = F.wave, g = lane >> 4, l15 = lane & 15;
    const bf16* gqk = (const bf16*)(p.ws + WS_IQ); const bf16* gv = (const bf16*)(p.ws + WS_DQ); const float* misc = (const float*)(p.ws + WS_MISC);
    bf16* qfp = (bf16*)(p.ws + WS_QFP); bf16* kdt = (bf16*)(p.ws + WS_KDT); bf16* sc = (bf16*)(p.ws + WS_SC); bf16* vt = (bf16*)(p.ws + WS_GVT); float* dec = (float*)(p.ws + WS_DCRAW);
    LAS unsigned char* lds = F.lds;
    LAS float* GA = (LAS float*)(lds + G1_GA); LAS float* TOT = (LAS float*)(lds + G1_TOT);
    for (int uu = F.bid; uu < 1024; uu += F.G) {
        const int b = uu >> 9, h = (uu >> 7) & 3, c = uu & 127; const size_t m0 = (size_t)b * SEQ + c * CHUNK;
        { const int e = tid * 2, t = e >> 4, j = e & 15; *(LAS f32x2*)(GA + t * 16 + j) = *(const f32x2*)(misc + (m0 + t) * 256 + 144 + j); }
        {
#pragma unroll
            for (int i = 0; i < 4; ++i) { const int e = tid + 512 * i, t = e >> 5, ch = e & 31;
                *(LAS u32x4*)(lds + 0 * G1_ARR + t * G1_ROW + ch * 16) = *(const u32x4*)(gqk + (m0 + t) * DM + h * GDK + ch * 8);
                *(LAS u32x4*)(lds + 3 * G1_ARR + t * G1_ROW + ch * 16) = *(const u32x4*)(gqk + (m0 + t) * DM + 1024 + h * GDK + ch * 8); }
        }
        const int half = tid >> 8, d = tid & 255;
        float w2[16];
#pragma unroll
        for (int j = 0; j < 16; ++j) w2[j] = KARG_IN(I_WA2)[j * 1024 + h * 256 + d];
        const float ba = KARG_IN(I_BA)[h * 256 + d];
        __syncthreads();
        float la[32]; float run = 0.f;
#pragma unroll
        for (int i = 0; i < 32; ++i) {
            const LAS f32x4* ga4 = (const LAS f32x4*)(GA + (32 * half + i) * 16);
            float x = ba;
#pragma unroll
            for (int j4 = 0; j4 < 4; ++j4) { const f32x4 a = ga4[j4]; x += a.x * w2[4 * j4] + a.y * w2[4 * j4 + 1] + a.z * w2[4 * j4 + 2] + a.w * w2[4 * j4 + 3]; }
            const float ls = fminf(x, 0.f) - __logf(1.0f + __expf(-fabsf(x)));
            run += ls * 0.0625f; la[i] = run;
        }
        TOT[half * 256 + d] = run;
        __syncthreads();
        const float off = half ? TOT[d] : 0.f, blast = TOT[d] + TOT[256 + d];
        unsigned kdp[16];
#pragma unroll
        for (int i = 0; i < 32; ++i) {
            const int t = 32 * half + i; const float bc = off + la[i];
            const float eb = __expf(bc), ebi = __expf(-bc);
            const float q = bf2f(*(const LAS bf16*)(lds + 0 * G1_ARR + t * G1_ROW + d * 2)) * 0.0625f, k = bf2f(*(const LAS bf16*)(lds + 3 * G1_ARR + t * G1_ROW + d * 2));
            const unsigned qq = cvt_pk_bf16(q * eb, q * ebi), kk = cvt_pk_bf16(k * eb, k * ebi);
            *(LAS bf16*)(lds + 0 * G1_ARR + t * G1_ROW + d * 2) = (bf16)(qq & 0xffffu);
            *(LAS bf16*)(lds + 2 * G1_ARR + t * G1_ROW + d * 2) = (bf16)(qq >> 16);
            *(LAS bf16*)(lds + 3 * G1_ARR + t * G1_ROW + d * 2) = (bf16)(kk & 0xffffu);
            *(LAS bf16*)(lds + 1 * G1_ARR + t * G1_ROW + d * 2) = (bf16)(kk >> 16);
            const float kd = k * __expf(blast - bc);
            if (i & 1) kdp[i >> 1] = cvt_pk_bf16(__uint_as_float(kdp[i >> 1]), kd); else kdp[i >> 1] = __float_as_uint(kd);
        }
        { bf16* kb = kdt + (((size_t)uu * 16 + (d >> 4)) * 2 + half) * 512 + (d & 15) * 8;
#pragma unroll
          for (int j = 0; j < 4; ++j) *(u32x4*)(kb + j * 128) = (u32x4){kdp[4 * j], kdp[4 * j + 1], kdp[4 * j + 2], kdp[4 * j + 3]}; }
        if (half == 0) dec[(size_t)uu * 256 + d] = __expf(blast);
        __syncthreads();
        {
#pragma unroll
            for (int bi = 0; bi < 4; ++bi) { const int blk = wave * 4 + bi, tt = blk >> 3, kk = blk & 7;
                const LAS unsigned char* rp = lds + 0 * G1_ARR + (16 * tt + l15) * G1_ROW + (32 * kk + 4 * g) * 2;
                const u32x2 p1 = *(const LAS u32x2*)rp, p2 = *(const LAS u32x2*)(rp + 32);
                *(u32x4*)(qfp + (((size_t)uu * 4 + tt) * 8 + kk) * 512 + lane * 8) = (u32x4){p1.x, p1.y, p2.x, p2.y}; }
        }
        {
            const int tm = wave >> 1, tn0 = (wave & 1) * 2;
            f32x4 lo[2], up[2];
#pragma unroll
            for (int j = 0; j < 2; ++j) { lo[j] = (f32x4){0.f, 0.f, 0.f, 0.f}; up[j] = (f32x4){0.f, 0.f, 0.f, 0.f}; }
#pragma unroll
            for (int ks = 0; ks < 8; ++ks) {
                const int ao = (16 * tm + l15) * G1_ROW + (32 * ks + 8 * g) * 2;
                const bf16x8 aF = *(const LAS bf16x8*)(lds + 0 * G1_ARR + ao), aB = *(const LAS bf16x8*)(lds + 2 * G1_ARR + ao);
#pragma unroll
                for (int j = 0; j < 2; ++j) {
                    const int bo = (16 * (tn0 + j) + l15) * G1_ROW + (32 * ks + 8 * g) * 2;
                    const bf16x8 bB = *(const LAS bf16x8*)(lds + 1 * G1_ARR + bo), bF = *(const LAS bf16x8*)(lds + 3 * G1_ARR + bo);
                    lo[j] = __builtin_amdgcn_mfma_f32_16x16x32_bf16(aF, bB, lo[j], 0, 0, 0);
                    up[j] = __builtin_amdgcn_mfma_f32_16x16x32_bf16(aB, bF, up[j], 0, 0, 0);
                }
            }
#pragma unroll
            for (int j = 0; j < 2; ++j) { const int s = 16 * (tn0 + j) + l15;
#pragma unroll
                for (int r = 0; r < 4; ++r) { const int t = 16 * tm + 4 * g + r; const float v = (s <= t) ? lo[j][r] : up[j][r];
                    sc[(((size_t)uu * 4 + tm) * 2 + (s >> 5)) * 512 + ((((s >> 3) & 3) * 16 + (t & 15)) * 8) + (s & 7)] = (bf16)(cvt_pk_bf16(v, 0.f) & 0xffffu); } }
        }
        __syncthreads();
#pragma unroll
        for (int i = 0; i < 8; ++i) { const int e = tid + 512 * i, t = e >> 6, ch = e & 63; *(LAS u32x4*)(lds + t * G1_VROW + ch * 16) = *(const u32x4*)(gv + (m0 + t) * DM + h * GDV + ch * 8); }
        __syncthreads();
        { unsigned vp[32];
#pragma unroll
          for (int i = 0; i < 32; ++i) { const unsigned a = *(const LAS bf16*)(lds + (2 * i) * G1_VROW + tid * 2), bb = *(const LAS bf16*)(lds + (2 * i + 1) * G1_VROW + tid * 2); vp[i] = a | (bb << 16); }
          bf16* vb = vt + (((size_t)uu * 32 + (tid >> 4)) * 2) * 512 + (tid & 15) * 8;
#pragma unroll
          for (int j = 0; j < 8; ++j) *(u32x4*)(vb + (j >> 2) * 512 + (j & 3) * 128) = (u32x4){vp[4 * j], vp[4 * j + 1], vp[4 * j + 2], vp[4 * j + 3]}; }
        __syncthreads();
    }
}

constexpr int G2_GRP = 16;
__device__ __forceinline__ void gla_scan_state(const Params& p, const Frame& F) {
    const int lane = F.lane, wave = F.wave, g = lane >> 4, l15 = lane & 15;
    const bf16* kdt = (const bf16*)(p.ws + WS_KDT); const bf16* vt = (const bf16*)(p.ws + WS_GVT); const float* dec = (const float*)(p.ws + WS_DCRAW);
    float* sloc = (float*)(p.ws + WS_S3);
    const int d0 = 4 * (wave & 3), n0 = 4 * (wave >> 2), lo_ = lane * 8;
    for (int uu = F.bid; uu < 256; uu += F.G) {
        const int bh = uu & 7, vq = (uu >> 3) & 3, grp = uu >> 5;
        const size_t ubase = (size_t)bh * 128 + grp * G2_GRP;
        f32x4 sa[4][4];
#pragma unroll
        for (int i = 0; i < 4; ++i)
#pragma unroll
            for (int nt = 0; nt < 4; ++nt) sa[i][nt] = (f32x4){0.f, 0.f, 0.f, 0.f};
        bf16x8 VTa[4][2], KDa[4][2], VTb[4][2], KDb[4][2]; f32x4 DCa[4], DCb[4];
#define G2A_LOAD(cc_, VT_, KD_, DC_) do { const size_t u1_ = ubase + (cc_); const bf16* vtu = vt + ((u1_ * 32 + vq * 8 + n0) * 2) * 512; const bf16* kdu = kdt + ((u1_ * 16 + d0) * 2) * 512; const float* dcu = dec + u1_ * 256 + 16 * d0; \
        _Pragma("unroll") for (int nt = 0; nt < 4; ++nt) { _Pragma("unroll") for (int kk = 0; kk < 2; ++kk) VT_[nt][kk] = *(const bf16x8*)((vtu + (nt * 2 + kk) * 512) + lo_); } \
        _Pragma("unroll") for (int i = 0; i < 4; ++i) { _Pragma("unroll") for (int kk = 0; kk < 2; ++kk) KD_[i][kk] = *(const bf16x8*)((kdu + (i * 2 + kk) * 512) + lo_); \
            DC_[i] = *(const f32x4*)(dcu + (4 * g + 16 * i)); } } while (0)
#define G2A_UPD(VT_, KD_, DC_) do { _Pragma("unroll") for (int i = 0; i < 4; ++i) { _Pragma("unroll") for (int nt = 0; nt < 4; ++nt) { sa[i][nt] = sa[i][nt] * DC_[i]; \
        sa[i][nt] = __builtin_amdgcn_mfma_f32_16x16x32_bf16(KD_[i][0], VT_[nt][0], sa[i][nt], 0, 0, 0); \
        sa[i][nt] = __builtin_amdgcn_mfma_f32_16x16x32_bf16(KD_[i][1], VT_[nt][1], sa[i][nt], 0, 0, 0); } } } while (0)
        G2A_LOAD(0, VTa, KDa, DCa);
#pragma unroll 1
        for (int cc = 0; cc < G2_GRP; cc += 2) {
            G2A_LOAD(cc + 1, VTb, KDb, DCb);
            G2A_UPD(VTa, KDa, DCa);
            if (cc + 2 < G2_GRP) G2A_LOAD(cc + 2, VTa, KDa, DCa);
            G2A_UPD(VTb, KDb, DCb);
        }
#undef G2A_LOAD
#undef G2A_UPD
        f32x4* ub = (f32x4*)(sloc + (size_t)uu * 32768);
#pragma unroll
        for (int i = 0; i < 4; ++i)
#pragma unroll
            for (int nt = 0; nt < 4; ++nt) { f32x4* tp = ub + ((d0 + i) * 8 + n0 + nt) * 64; tp[(unsigned)lane] = sa[i][nt]; }
    }
}
constexpr int G2L_SB = 0, G2L_QF = 65536, G2L_KD = 98304, G2L_VT = 131072, G2L_SC = 147456;
static_assert(G2L_SC + 8192 <= MISC_OFF, "scan lds");
__device__ __forceinline__ void gla_scan_full(const Params& p, const Frame& F, bf16* oraw) {
    const int lane = F.lane, wave = F.wave, g = lane >> 4, l15 = lane & 15;
    const bf16* qfp = (const bf16*)(p.ws + WS_QFP); const bf16* kdt = (const bf16*)(p.ws + WS_KDT); const bf16* sc = (const bf16*)(p.ws + WS_SC); const bf16* vt = (const bf16*)(p.ws + WS_GVT); const float* dec = (const float*)(p.ws + WS_DCRAW);
    const float* sloc = (const float*)(p.ws + WS_S3);
    LAS unsigned char* lds = F.lds;
    const int tw = wave & 3, d0 = 4 * (wave & 3), n0 = 4 * (wave >> 2);
#define G2D_COPY(gsrc_, ldsoff_, nblk_) do { _Pragma("unroll") for (int b_ = 0; b_ < (nblk_); ++b_) \
        __builtin_amdgcn_global_load_lds((const unsigned*)((const char*)(gsrc_) + (size_t)(wave * (nblk_) + b_) * 1024 + lane * 16), (LAS unsigned*)(lds + (ldsoff_) + (wave * (nblk_) + b_) * 1024), 16, 0, 0); } while (0)
#define G2D_ISSUE_QF(cc_) do { const size_t u1_ = ubase + (cc_); G2D_COPY(qfp + u1_ * 16384, G2L_QF, 4); } while (0)
#define G2D_ISSUE_VKS(cc_) do { const size_t u1_ = ubase + (cc_); G2D_COPY(vt + (u1_ * 32 + vq * 8) * 1024, G2L_VT, 2); G2D_COPY(kdt + u1_ * 16384, G2L_KD, 4); G2D_COPY(sc + u1_ * 4096, G2L_SC, 1); } while (0)
#define G2D_PUBLISH() do { _Pragma("unroll") for (int nt = 0; nt < 4; ++nt) { _Pragma("unroll") for (int j = 0; j < 2; ++j) { u32x4 w; \
        w.x = cvt_pk_bf16(sa[2 * j][nt][0], sa[2 * j][nt][1]); w.y = cvt_pk_bf16(sa[2 * j][nt][2], sa[2 * j][nt][3]); w.z = cvt_pk_bf16(sa[2 * j + 1][nt][0], sa[2 * j + 1][nt][1]); w.w = cvt_pk_bf16(sa[2 * j + 1][nt][2], sa[2 * j + 1][nt][3]); \
        *(LAS u32x4*)(lds + G2L_SB + ((n0 + nt) * 8 + 2 * tw + j) * 1024 + lane * 16) = w; } } } while (0)
#define G2D_BAR() do { asm volatile("s_waitcnt vmcnt(0) lgkmcnt(0)" ::: "memory"); __syncthreads(); } while (0)
    for (int uu = F.bid; uu < 256; uu += F.G) {
        const int bh = uu & 7, vq = (uu >> 3) & 3, grp = uu >> 5;
        const size_t ubase = (size_t)bh * 128 + grp * G2_GRP;
        G2D_ISSUE_VKS(0); G2D_ISSUE_QF(0);
        f32x4 sa[4][4];
#pragma unroll
        for (int i = 0; i < 4; ++i)
#pragma unroll
            for (int nt = 0; nt < 4; ++nt) sa[i][nt] = (f32x4){0.f, 0.f, 0.f, 0.f};
#pragma unroll 1
        for (int j = 0; j < grp; ++j) {
            f32x4 D[4];
#pragma unroll
            for (int i = 0; i < 4; ++i) { D[i] = (f32x4){1.f, 1.f, 1.f, 1.f};
                for (int c2 = 0; c2 < G2_GRP; ++c2) D[i] = D[i] * *(const f32x4*)(dec + ((size_t)bh * 128 + j * G2_GRP + c2) * 256 + 16 * (d0 + i) + 4 * g); }
            const f32x4* ub = (const f32x4*)(sloc + (size_t)(bh + 8 * vq + 32 * j) * 32768);
            unsigned lj = (unsigned)lane; asm volatile("" : "+v"(lj));
#pragma unroll
            for (int i = 0; i < 4; ++i)
#pragma unroll
                for (int nt = 0; nt < 4; ++nt) { const f32x4* tp = ub + ((d0 + i) * 8 + n0 + nt) * 64; sa[i][nt] = sa[i][nt] * D[i] + tp[lj]; }
        }
        G2D_PUBLISH();
        G2D_BAR();
#pragma unroll 1
        for (int cc = 0; cc < G2_GRP; ++cc) {
            const int c = grp * G2_GRP + cc;
            f32x4 DC[4];
            { const float* dcu = dec + (ubase + cc) * 256 + 16 * d0;
#pragma unroll
              for (int i = 0; i < 4; ++i) DC[i] = *(const f32x4*)(dcu + (4 * g + 16 * i)); }
            f32x4 o[4];
#pragma unroll
            for (int ntl = 0; ntl < 4; ++ntl) o[ntl] = (f32x4){0.f, 0.f, 0.f, 0.f};
#pragma unroll
            for (int kk = 0; kk < 8; ++kk) {
                const bf16x8 qf = *(const LAS bf16x8*)(lds + G2L_QF + (tw * 8 + kk) * 1024 + lane * 16);
#pragma unroll
                for (int ntl = 0; ntl < 4; ++ntl) { const bf16x8 sb = *(const LAS bf16x8*)(lds + G2L_SB + ((n0 + ntl) * 8 + kk) * 1024 + lane * 16); o[ntl] = __builtin_amdgcn_mfma_f32_16x16x32_bf16(qf, sb, o[ntl], 0, 0, 0); }
            }
            G2D_BAR();
            if (cc + 1 < G2_GRP) G2D_ISSUE_QF(cc + 1);
            bf16x8 VT[4][2];
#pragma unroll
            for (int nt = 0; nt < 4; ++nt)
#pragma unroll
                for (int kk = 0; kk < 2; ++kk) VT[nt][kk] = *(const LAS bf16x8*)(lds + G2L_VT + ((n0 + nt) * 2 + kk) * 1024 + lane * 16);
            { const bf16x8 s0 = *(const LAS bf16x8*)(lds + G2L_SC + (tw * 2 + 0) * 1024 + lane * 16), s1 = *(const LAS bf16x8*)(lds + G2L_SC + (tw * 2 + 1) * 1024 + lane * 16);
#pragma unroll
              for (int ntl = 0; ntl < 4; ++ntl) {
                o[ntl] = __builtin_amdgcn_mfma_f32_16x16x32_bf16(s0, VT[ntl][0], o[ntl], 0, 0, 0);
                o[ntl] = __builtin_amdgcn_mfma_f32_16x16x32_bf16(s1, VT[ntl][1], o[ntl], 0, 0, 0);
                bf16* od = oraw + ((size_t)(bh * 32 + vq * 8 + n0 + ntl) * SEQ + c * CHUNK + 16 * tw + 4 * g) * 16 + l15;
#pragma unroll
                for (int r = 0; r < 4; ++r) od[r * 16] = (bf16)(cvt_pk_bf16(o[ntl][r], 0.f) & 0xffffu);
              } }
#pragma unroll
            for (int i = 0; i < 4; ++i) {
                const bf16x8 k0 = *(const LAS bf16x8*)(lds + G2L_KD + ((d0 + i) * 2 + 0) * 1024 + lane * 16), k1 = *(const LAS bf16x8*)(lds + G2L_KD + ((d0 + i) * 2 + 1) * 1024 + lane * 16);
#pragma unroll
                for (int nt = 0; nt < 4; ++nt) { sa[i][nt] = sa[i][nt] * DC[i];
                    sa[i][nt] = __builtin_amdgcn_mfma_f32_16x16x32_bf16(k0, VT[nt][0], sa[i][nt], 0, 0, 0);
                    sa[i][nt] = __builtin_amdgcn_mfma_f32_16x16x32_bf16(k1, VT[nt][1], sa[i][nt], 0, 0, 0); }
            }
            G2D_PUBLISH();
            G2D_BAR();
            if (cc + 1 < G2_GRP) G2D_ISSUE_VKS(cc + 1);
        }
        G2D_BAR();
    }
#undef G2D_COPY
#undef G2D_ISSUE_QF
#undef G2D_ISSUE_VKS
#undef G2D_PUBLISH
#undef G2D_BAR
}

__device__ __forceinline__ void p8_gla3(const Params& p, const Frame& F) {
    const int gw = F.bid * NWAVES + F.wave, NGW = F.G * NWAVES, lane = F.lane;
    const bf16* oraw = (const bf16*)(p.ws + WS_DQ); const bf16* gr = (const bf16*)(p.ws + WS_GR); bf16* yg = (bf16*)(p.ws + WS_S2);
    const f32x4 g0 = ((const f32x4*)KARG_IN(I_GONORM))[2 * lane], g1 = ((const f32x4*)KARG_IN(I_GONORM))[2 * lane + 1];
    const float gg[8] = {g0.x, g0.y, g0.z, g0.w, g1.x, g1.y, g1.z, g1.w};
    for (int m4 = gw * 4; m4 < M; m4 += NGW * 4) {
        const int b = m4 >> 13, t4 = m4 & (SEQ - 1);
        u32x4 ow[4][4], rw[4][4];
#pragma unroll
        for (int k = 0; k < 4; ++k)
#pragma unroll
            for (int hh = 0; hh < GH; ++hh) {
                ow[k][hh] = *(const u32x4*)(oraw + ((size_t)((b * GH + hh) * 32 + (lane >> 1)) * SEQ + t4 + k) * 16 + (lane & 1) * 8);
                rw[k][hh] = *((const u32x4*)(gr + (size_t)(m4 + k) * DM + hh * GDV) + lane); }
#pragma unroll
        for (int k = 0; k < 4; ++k)
#pragma unroll
            for (int hh = 0; hh < GH; ++hh) {
                const u32x4 a = ow[k][hh], rr = rw[k][hh];
                float o[8] = {bf_lo(a.x), bf_hi(a.x), bf_lo(a.y), bf_hi(a.y), bf_lo(a.z), bf_hi(a.z), bf_lo(a.w), bf_hi(a.w)};
                const float r[8] = {bf_lo(rr.x), bf_hi(rr.x), bf_lo(rr.y), bf_hi(rr.y), bf_lo(rr.z), bf_hi(rr.z), bf_lo(rr.w), bf_hi(rr.w)};
                float ss = 0.f;
#pragma unroll
                for (int e = 0; e < 8; ++e) ss += o[e] * o[e];
                const float rstd = rsqrtf(wave_sum(ss) * (1.f / GDV) + EPS);
#pragma unroll
                for (int e = 0; e < 8; ++e) o[e] = o[e] * rstd * gg[e] * (r[e] * sigmoidf_(r[e]));
                u32x4 w; w.x = cvt_pk_bf16(o[0], o[1]); w.y = cvt_pk_bf16(o[2], o[3]); w.z = cvt_pk_bf16(o[4], o[5]); w.w = cvt_pk_bf16(o[6], o[7]);
                *((u32x4*)(yg + (size_t)(m4 + k) * DM + hh * GDV) + lane) = w;
            }
    }
}

__device__ __forceinline__ void xa_vt_relayout(const Params& p, const Frame& F) {
    const bf16* kv = (const bf16*)(p.ws + WS_KV); bf16* vT = (bf16*)(p.ws + WS_VT);
    for (int i = F.bid * NTHR + F.tid; i < NB * XH * XDH * NMEM; i += F.G * NTHR) {
        const int pos = i & 255, d = (i >> 8) & 511, h = (i >> 17) & 3, b = i >> 19;
        const int mem = (pos & ~31) + 16 * ((pos >> 2) & 1) + 4 * ((pos >> 3) & 3) + (pos & 3);
        vT[i] = kv[(size_t)(b * NMEM + mem) * 4096 + 2048 + h * XDH + d];
    }
}
constexpr int XA_KROW = 1056, XA_KBUF = 32 * XA_KROW, XA_VROW = 544, XA_VBUF = 32 * XA_VROW, XA_VOFF = 2 * XA_KBUF;
static_assert(XA_VOFF + 2 * XA_VBUF <= MISC_OFF, "xa lds");
__device__ __forceinline__ void p13_xattn(const Params& p, const Frame& F) {
    const int lane = F.lane, wave = F.wave, tid = F.tid, g = lane >> 4, l15 = lane & 15;
    const bf16* qx = (const bf16*)(p.ws + WS_YDSA); const bf16* kv = (const bf16*)(p.ws + WS_KV); const bf16* vT = (const bf16*)(p.ws + WS_VT);
    bf16* o = (bf16*)(p.ws + WS_IQ);
    LAS unsigned char* lds = F.lds;
    const float SCL = 0.044194173824159216f;
    for (int uu = F.bid; uu < 512; uu += F.G) {
        const int b = uu >> 8, h = (uu >> 6) & 3, tb = uu & 63; const size_t m0 = (size_t)b * SEQ + tb * 128 + wave * 16;
        bf16x8 bq[16];
        { const bf16* qs = qx + (m0 + l15) * DM + h * XDH + 8 * g;
#pragma unroll
          for (int kk = 0; kk < 16; ++kk) bq[kk] = *(const bf16x8*)(qs + 32 * kk); }
        const bf16* kbase = kv + (size_t)(b * NMEM) * 4096 + h * XDH;
        const bf16* vbase = vT + (size_t)(b * XH + h) * XDH * NMEM;
        u32x4 st[4];
#pragma unroll
        for (int i = 0; i < 4; ++i) { const int e = tid + 512 * i, row = e >> 6, ch = e & 63; st[i] = *(const u32x4*)(kbase + (size_t)row * 4096 + ch * 8); }
#pragma unroll
        for (int i = 0; i < 4; ++i) { const int e = tid + 512 * i, row = e >> 6, ch = e & 63; *(LAS u32x4*)(lds + row * XA_KROW + ch * 16) = st[i]; }
        __syncthreads();
        f32x4 sT[16];
#pragma unroll
        for (int kt = 0; kt < 8; ++kt) {
            LAS unsigned char* kb = lds + (kt & 1) * XA_KBUF;
            if (kt + 1 < 8) {
#pragma unroll
                for (int i = 0; i < 4; ++i) { const int e = tid + 512 * i, row = e >> 6, ch = e & 63; st[i] = *(const u32x4*)(kbase + (size_t)(32 * (kt + 1) + row) * 4096 + ch * 8); }
            }
#pragma unroll
            for (int sub = 0; sub < 2; ++sub) {
                f32x4 a4 = (f32x4){0.f, 0.f, 0.f, 0.f};
#pragma unroll
                for (int kk = 0; kk < 16; ++kk) { const bf16x8 a = *(const LAS bf16x8*)(kb + (16 * sub + l15) * XA_KROW + kk * 64 + g * 16); a4 = __builtin_amdgcn_mfma_f32_16x16x32_bf16(a, bq[kk], a4, 0, 0, 0); }
                sT[2 * kt + sub] = a4;
            }
            if (kt + 1 < 8) {
                LAS unsigned char* nb = lds + ((kt + 1) & 1) * XA_KBUF;
#pragma unroll
                for (int i = 0; i < 4; ++i) { const int e = tid + 512 * i, row = e >> 6, ch = e & 63; *(LAS u32x4*)(nb + row * XA_KROW + ch * 16) = st[i]; }
            }
            __syncthreads();
        }
#pragma unroll
        for (int i = 0; i < 2; ++i) { const int e = tid + 512 * i, row = e >> 5, ch = e & 31; st[i] = *(const u32x4*)(vbase + (size_t)row * NMEM + ch * 8); }
        float mx = -INFINITY;
#pragma unroll
        for (int mt = 0; mt < 16; ++mt) mx = fmaxf(mx, fmaxf(fmaxf(sT[mt][0], sT[mt][1]), fmaxf(sT[mt][2], sT[mt][3])));
        mx = x16_max(mx); mx = x32_max(mx);
        float sum = 0.f;
#pragma unroll
        for (int mt = 0; mt < 16; ++mt) {
#pragma unroll
            for (int r = 0; r < 4; ++r) { const float e = __expf((sT[mt][r] - mx) * SCL); sT[mt][r] = e; sum += e; } }
        sum = x16_sum(sum); sum = x32_sum(sum);
        const float inv = __frcp_rn(sum);
        bf16x8 pf[8];
#pragma unroll
        for (int kk = 0; kk < 8; ++kk) { u32x4 w; w.x = cvt_pk_bf16(sT[2 * kk][0], sT[2 * kk][1]); w.y = cvt_pk_bf16(sT[2 * kk][2], sT[2 * kk][3]); w.z = cvt_pk_bf16(sT[2 * kk + 1][0], sT[2 * kk + 1][1]); w.w = cvt_pk_bf16(sT[2 * kk + 1][2], sT[2 * kk + 1][3]);
            pf[kk] = __builtin_bit_cast(bf16x8, w); }
#pragma unroll
        for (int i = 0; i < 2; ++i) { const int e = tid + 512 * i, row = e >> 5, ch = e & 31; *(LAS u32x4*)(lds + XA_VOFF + row * XA_VROW + ch * 16) = st[i]; }
        __syncthreads();
        bf16* od = o + (m0 + l15) * DM + h * XDH + 4 * g;
        for (int vt = 0; vt < 16; ++vt) {
            LAS unsigned char* vb = lds + XA_VOFF + (vt & 1) * XA_VBUF;
            if (vt + 1 < 16) {
#pragma unroll
                for (int i = 0; i < 2; ++i) { const int e = tid + 512 * i, row = e >> 5, ch = e & 31; st[i] = *(const u32x4*)(vbase + (size_t)(32 * (vt + 1) + row) * NMEM + ch * 8); }
            }
#pragma unroll
            for (int sub = 0; sub < 2; ++sub) {
                f32x4 a4 = (f32x4){0.f, 0.f, 0.f, 0.f};
#pragma unroll
                for (int kk = 0; kk < 8; ++kk) { const bf16x8 a = *(const LAS bf16x8*)(vb + (16 * sub + l15) * XA_VROW + kk * 64 + g * 16); a4 = __builtin_amdgcn_mfma_f32_16x16x32_bf16(a, pf[kk], a4, 0, 0, 0); }
                u32x2 w; w.x = cvt_pk_bf16(a4[0] * inv, a4[1] * inv); w.y = cvt_pk_bf16(a4[2] * inv, a4[3] * inv);
                *(u32x2*)(od + 16 * (2 * vt + sub)) = w;
            }
            if (vt + 1 < 16) {
                LAS unsigned char* nb = lds + XA_VOFF + ((vt + 1) & 1) * XA_VBUF;
#pragma unroll
                for (int i = 0; i < 2; ++i) { const int e = tid + 512 * i, row = e >> 5, ch = e & 31; *(LAS u32x4*)(nb + row * XA_VROW + ch * 16) = st[i]; }
            }
            __syncthreads();
        }
    }
}

__device__ __forceinline__ float pval_(unsigned u, int mode) {
    float v = mode == 1 ? (float)(u >> 16) * (1.f / 8192.f) : mode == 2 ? __uint_as_float(u) : bf_hi(u);
    if (!(v == v)) v = 3.f;
    return fminf(fmaxf(v, -4.f), 4.f);
}
struct PReg { int a, b, mode; };
template <int K> __device__ __forceinline__ void probe_run(const Params& p, int bid, int G, int wave) {
    constexpr PReg R[19][4] = {
        {{1, 7, 0}, {64, 122, 0}, {128, 192, 0}, {0, 0, 0}},
        {{192, 320, 0}, {27, 59, 2}, {0, 0, 0}, {0, 0, 0}},
        {{7, 19, 0}, {-1, 0, 0}, {0, 0, 0}, {0, 0, 0}},
        {{19, 27, 1}, {0, 0, 0}, {0, 0, 0}, {0, 0, 0}},
        {{-1, 0, 0}, {0, 0, 0}, {0, 0, 0}, {0, 0, 0}},
        {{448, 512, 0}, {0, 0, 0}, {0, 0, 0}, {0, 0, 0}},
        {{192, 384, 0}, {-1, 0, 0}, {0, 0, 0}, {0, 0, 0}},
        {{128, 192, 0}, {384, 448, 0}, {64, 96, 0}, {27, 28, 2}},
        {{256, 320, 0}, {0, 0, 0}, {0, 0, 0}, {0, 0, 0}},
        {{128, 192, 0}, {384, 416, 0}, {0, 0, 0}, {0, 0, 0}},
        {{-1, 0, 0}, {192, 256, 0}, {104, 108, 0}, {0, 0, 0}},
        {{448, 512, 0}, {108, 110, 0}, {0, 0, 0}, {0, 0, 0}},
        {{-1, 0, 2}, {128, 192, 0}, {256, 322, 0}, {0, 0, 0}},
        {{448, 512, 0}, {0, 0, 0}, {0, 0, 0}, {0, 0, 0}},
        {{192, 256, 0}, {0, 0, 0}, {0, 0, 0}, {0, 0, 0}},
        {{448, 512, 0}, {0, 0, 0}, {0, 0, 0}, {0, 0, 0}},
        {{-1, 0, 2}, {128, 192, 0}, {0, 0, 0}, {0, 0, 0}},
        {{328, 504, 0}, {0, 0, 0}, {0, 0, 0}, {0, 0, 0}},
        {{192, 256, 0}, {0, 0, 0}, {0, 0, 0}, {0, 0, 0}},
    };
    const int gt = bid * NTHR + wave * 64 + fresh_lane(), NT = G * NTHR;
    float* tmp = (float*)(p.ws + 512 * 1024);
    float ds = 0.f; bool has_d = false;
#pragma unroll
    for (int r = 0; r < 4; ++r) if (R[K][r].a < 0) { has_d = true; const unsigned* o32 = (const unsigned*)p.out; for (int j = gt; j < M * DM; j += NT) ds += pval_(o32[j], R[K][r].mode); }
    if (has_d) tmp[gt & 131071] = ds * (1.f / 64.f);
}
template <int K> __device__ __forceinline__ void probe_out(const Params& p, int bid, int G, int wave) {
    constexpr PReg R[19][4] = {
        {{1, 7, 0}, {64, 122, 0}, {128, 192, 0}, {0, 0, 0}}, {{192, 320, 0}, {27, 59, 2}, {0, 0, 0}, {0, 0, 0}}, {{7, 19, 0}, {-1, 0, 0}, {0, 0, 0}, {0, 0, 0}}, {{19, 27, 1}, {0, 0, 0}, {0, 0, 0}, {0, 0, 0}},
        {{-1, 0, 0}, {0, 0, 0}, {0, 0, 0}, {0, 0, 0}}, {{448, 512, 0}, {0, 0, 0}, {0, 0, 0}, {0, 0, 0}}, {{192, 384, 0}, {-1, 0, 0}, {0, 0, 0}, {0, 0, 0}}, {{128, 192, 0}, {384, 448, 0}, {64, 96, 0}, {27, 28, 2}},
        {{256, 320, 0}, {0, 0, 0}, {0, 0, 0}, {0, 0, 0}}, {{128, 192, 0}, {384, 416, 0}, {0, 0, 0}, {0, 0, 0}}, {{-1, 0, 0}, {192, 256, 0}, {104, 108, 0}, {0, 0, 0}}, {{448, 512, 0}, {108, 110, 0}, {0, 0, 0}, {0, 0, 0}},
        {{-1, 0, 2}, {128, 192, 0}, {256, 322, 0}, {0, 0, 0}}, {{448, 512, 0}, {0, 0, 0}, {0, 0, 0}, {0, 0, 0}}, {{192, 256, 0}, {0, 0, 0}, {0, 0, 0}, {0, 0, 0}}, {{448, 512, 0}, {0, 0, 0}, {0, 0, 0}, {0, 0, 0}},
        {{-1, 0, 2}, {128, 192, 0}, {0, 0, 0}, {0, 0, 0}}, {{328, 504, 0}, {0, 0, 0}, {0, 0, 0}, {0, 0, 0}}, {{192, 256, 0}, {0, 0, 0}, {0, 0, 0}, {0, 0, 0}},
    };
    const int gt = bid * NTHR + wave * 64 + fresh_lane(), NT = G * NTHR;
    const float* tmp = (const float*)(p.ws + 512 * 1024);
    for (int i = gt; i < M * DM; i += NT) {
        float acc = 0.f;
#pragma unroll
        for (int r = 0; r < 4; ++r) {
            if (R[K][r].a < 0) acc += tmp[i & 131071];
            else if (R[K][r].b > R[K][r].a) { const unsigned* w32 = (const unsigned*)(p.ws + (size_t)R[K][r].a * MiB); const int nw = (R[K][r].b - R[K][r].a) * (int)(MiB / 4);
                for (int j = i; j < nw; j += M * DM) acc += pval_(w32[j], R[K][r].mode); }
        }
        p.out[i] = acc;
    }
}
#define PROBE_EXIT(k) do { if (STOP_AFTER == (k)) { probe_run<(k)>(p, F.bid, F.G, F.wave); GRID_BAR(); probe_out<(k)>(p, F.bid, F.G, F.wave); return; } } while (0)


__device__ __forceinline__ void l2_scrub(const float* x, int bid, int tid) {
    const f32x4* s = (const f32x4*)x + (size_t)(bid & 255) * 32768 + tid; f32x4 a = (f32x4){0.f, 0.f, 0.f, 0.f};
#pragma unroll 8
    for (int i = 0; i < 64; ++i) { const f32x4 v = __builtin_nontemporal_load(s + i * 512); a += v; }
    asm volatile("" :: "v"(a.x + a.y + a.z + a.w));
}

#define NONDET_TEST 0
#ifndef DBL_MASK
#define DBL_MASK 0
#endif
#define L2_SCRUB 0
#define G2_TWICE 0
#define NAN_SCRUB 0
#define P11_NOCONV 0
#ifndef PH_MASK
#define PH_MASK 0xffffffffu
#endif
#ifndef STOP_AFTER
#define STOP_AFTER 99
#endif
__global__ void __launch_bounds__(NTHR, 2) fwd_kernel(Params p) {
    extern __shared__ __attribute__((aligned(16))) unsigned char lds_raw[];
    Frame F;
    F.lds = (LAS unsigned char*)lds_raw;
    F.tid = threadIdx.x; F.lane = F.tid & 63; F.wave = __builtin_amdgcn_readfirstlane(F.tid >> 6);
    F.G = gridDim.x; F.bid = blockIdx.x;
    volatile LAS unsigned* MISC = (volatile LAS unsigned*)(F.lds + MISC_OFF);
    if (F.tid < 64) MISC[F.tid] = 0u;
    __syncthreads();
    unsigned char* ws = p.ws;
    XcdBarrier bar = xcd_barrier_post((unsigned*)(ws + WS_CTL) + CW_BAR, MISC + 8, F.wave);
#define GRID_BAR() xcd_barrier(bar)
#define FRESH() const int l_ = fresh_lane(); F.lane = l_; F.tid = F.wave * 64 + l_; \
    LAS float* cscr = (LAS float*)(F.lds + F.wave * 16384); const int gw = F.bid * NWAVES + F.wave, NGW = F.G * NWAVES; (void)cscr; (void)gw; (void)NGW
    bf16* S1 = (bf16*)(ws + WS_S1); (void)S1;
    bf16* U = (bf16*)(ws + WS_S2);
    bf16* B3 = (bf16*)(ws + WS_S3);
    bf16* B4 = (bf16*)(ws + WS_S4);
    bf16* B5 = (bf16*)(ws + WS_S5);
    bf16* B7 = (bf16*)(ws + WS_S7);
    bf16* OUTB = (bf16*)p.out;
    pg8::StaticOrder SO;

    { FRESH(); if (PH_MASK & (1u << 0)) p0_prologue(p, F); if (DBL_MASK & 32) p0_prologue(p, F); }
    GRID_BAR();
    PROBE_EXIT(0);
    { pg8::Gemm g{U, (const bf16*)(ws + WS_W1A), M, 4608, DM, DM, 0, 0}; SO.init(M, 4608, F.G, F.bid);
      pg8::EpiP1a E{B3, B4, (float*)(ws + WS_DCRAW), (float*)(ws + WS_MISC)};
      pg8::gemm_phase<pg8::EpiP1a, pg8::StaticOrder>(F.lds, g, SO, E, F.wave); }
    { pg8::Gemm g{(const bf16*)(ws + WS_MEMN), (const bf16*)(ws + WS_WXKV0), NB * NMEM, 2 * DM, DM, DM, 0, 0}; SO.init(NB * NMEM, 2 * DM, F.G, (F.G == 256 && F.bid >= 128) ? F.bid - 128 : (F.G == 256 ? (1 << 20) : F.bid));
      pg8::EpiPlain E{(bf16*)(ws + WS_KV), 2 * DM};
      pg8::gemm_phase<pg8::EpiPlain, pg8::StaticOrder>(F.lds, g, SO, E, F.wave); }
    GRID_BAR();
    PROBE_EXIT(1);
    { FRESH(); if (PH_MASK & (1u << 1)) p2_norms(p, F); }
    { pg8::Gemm g{B4, (const bf16*)(ws + WS_BTUK), M, 4096, 256, DM, 256, 1}; SO.init(M, 4096, F.G, F.bid);
      pg8::EpiPlain E{OUTB, 4096};
      pg8::gemm_phase<pg8::EpiPlain, pg8::StaticOrder>(F.lds, g, SO, E, F.wave); }
    GRID_BAR();
    PROBE_EXIT(2);
    { FRESH(); if (PH_MASK & (1u << 2)) p3_indexer<(DBL_MASK & 1) ? 2 : 1>(p, F);
      VM_WAIT(); __builtin_amdgcn_fence(__ATOMIC_ACQUIRE, "agent"); VM_WAIT(); __syncthreads();
      if (PH_MASK & (1u << 3)) p4_dsa(p, F); }
    GRID_BAR();
    PROBE_EXIT(4);
    { pg8::Gemm g{OUTB, (const bf16*)(ws + WS_BTUV), M, DM, 512, 4096, 512, 0}; SO.init(M, DM, F.G, F.bid);
      pg8::EpiPlain E{B7, DM};
      pg8::gemm_phase<pg8::EpiPlain, pg8::StaticOrder>(F.lds, g, SO, E, F.wave); }
    GRID_BAR();
    PROBE_EXIT(5);
    { pg8::Gemm g{U, (const bf16*)(ws + WS_W1B), M, 10240, DM, DM, 0, 0}; SO.init(M, 10240, F.G, F.bid);
      pg8::EpiP1b E{B3, B4, B5, OUTB, OUTB + (size_t)M * DM};
      pg8::gemm_phase<pg8::EpiP1b, pg8::StaticOrder>(F.lds, g, SO, E, F.wave); }
    GRID_BAR();
    PROBE_EXIT(6);
    { FRESH(); if (PH_MASK & (1u << 4)) p6_gla1(p, F); if (DBL_MASK & 2) p6_gla1(p, F);
    conv_seg(KARG_IN(I_WGB), DM, DM, 0, DM, (bf16*)(ws + WS_WGB), DM, 0, 0, cscr, gw, NGW, F.lane);
    conv_seg(KARG_IN(I_WDB), DM, DM, 0, DM, (bf16*)(ws + WS_WDB), DM, 0, 0, cscr, gw, NGW, F.lane);
    conv_seg(KARG_IN(I_WMIX), DM, DM, 0, DM, (bf16*)(ws + WS_WMIX), DM, 0, 0, cscr, gw, NGW, F.lane); }
    GRID_BAR();
    PROBE_EXIT(7);
    { FRESH(); gla_scan_state(p, F); if (DBL_MASK & 4) gla_scan_state(p, F); }
    GRID_BAR();
    { FRESH(); gla_scan_full(p, F, (bf16*)(ws + WS_DQ)); if (DBL_MASK & 256) gla_scan_full(p, F, (bf16*)(ws + WS_DQ)); }
    GRID_BAR();
    PROBE_EXIT(8);
    { FRESH(); if (L2_SCRUB) l2_scrub(KARG_IN(I_X), F.bid, F.tid); if (PH_MASK & (1u << 6)) p8_gla3(p, F); if (DBL_MASK & 8) p8_gla3(p, F);
    conv_seg(KARG_IN(I_WXQ), DM, DM, 0, DM, (bf16*)(ws + WS_WXQ), DM, 0, 0, cscr, gw, NGW, F.lane);
    conv_seg(KARG_IN(I_WXO), DM, DM, 0, DM, (bf16*)(ws + WS_WXO), DM, 0, 0, cscr, gw, NGW, F.lane); }
    GRID_BAR();
    PROBE_EXIT(9);
    { pg8::Gemm g{B7, (const bf16*)(ws + WS_WDB), M, DM, DM, DM, 0, 0}; SO.init(M, DM, F.G, F.bid);
      pg8::EpiGateMul E{OUTB + (size_t)M * DM};
      pg8::gemm_phase<pg8::EpiGateMul, pg8::StaticOrder>(F.lds, g, SO, E, F.wave); }
    { pg8::Gemm g{U, (const bf16*)(ws + WS_WGB), M, DM, DM, DM, 0, 0}; SO.init(M, DM, F.G, F.bid);
      pg8::EpiMerge E{OUTB, OUTB + (size_t)M * DM, B3};
      pg8::gemm_phase<pg8::EpiMerge, pg8::StaticOrder>(F.lds, g, SO, E, F.wave); }
    GRID_BAR();
    PROBE_EXIT(10);
    { pg8::Gemm g{B3, (const bf16*)(ws + WS_WMIX), M, DM, DM, DM, 0, 0}; SO.init(M, DM, F.G, F.bid);
      pg8::EpiPlain E{B7, DM};
      pg8::gemm_phase<pg8::EpiPlain, pg8::StaticOrder>(F.lds, g, SO, E, F.wave); }
    { FRESH(); xa_vt_relayout(p, F); }
    GRID_BAR();
    PROBE_EXIT(11);
    { FRESH(); for (int m = gw; m < M; m += NGW) resid_row(KARG_IN(I_X) + (size_t)m * DM, B7 + (size_t)m * DM, KARG_IN(I_MIXPOST), p.out + (size_t)m * DM, KARG_IN(I_XAPRE), U + (size_t)m * DM, F.lane);
    if (!P11_NOCONV) for (int it = gw; it < 88 * 64; it += NGW) { const int jj = it >> 6, sub = it & 63;
        conv_item((jj & 1) ? KARG_IN(I_WFU) : KARG_IN(I_WFG), DFF, (jj >> 1) * 128, 128, (bf16*)(ws + WS_WFGU), DM, 0, (jj >> 1) * 256 + (jj & 1) * 128, cscr, sub, F.lane); }
    if (!P11_NOCONV) conv_seg(KARG_IN(I_WFD), DM, DFF, 0, DM, (bf16*)(ws + WS_WFD), DFF, 0, 0, cscr, gw, NGW, F.lane); }
    GRID_BAR();
    PROBE_EXIT(12);
    { pg8::Gemm g{U, (const bf16*)(ws + WS_WXQ), M, DM, DM, DM, 0, 0}; SO.init(M, DM, F.G, F.bid);
      pg8::EpiPlain E{B7, DM};
      pg8::gemm_phase<pg8::EpiPlain, pg8::StaticOrder>(F.lds, g, SO, E, F.wave); }
    GRID_BAR();
    PROBE_EXIT(13);
    { FRESH(); if (PH_MASK & (1u << 7)) p13_xattn(p, F); if (DBL_MASK & 16) p13_xattn(p, F); }
    GRID_BAR();
    PROBE_EXIT(14);
    { pg8::Gemm g{B3, (const bf16*)(ws + WS_WXO), M, DM, DM, DM, 0, 0}; SO.init(M, DM, F.G, F.bid);
      pg8::EpiPlain E{B7, DM};
      pg8::gemm_phase<pg8::EpiPlain, pg8::StaticOrder>(F.lds, g, SO, E, F.wave); }
    GRID_BAR();
    PROBE_EXIT(15);
    { FRESH(); for (int m = gw; m < M; m += NGW) resid_row(p.out + (size_t)m * DM, B7 + (size_t)m * DM, KARG_IN(I_XAPOST), p.out + (size_t)m * DM, KARG_IN(I_FFPRE), U + (size_t)m * DM, F.lane); }
    GRID_BAR();
    PROBE_EXIT(16);
    { pg8::Gemm g{U, (const bf16*)(ws + WS_WFGU), M, 2 * DFF, DM, DM, 0, 0}; SO.init(M, 2 * DFF, F.G, F.bid);
      pg8::EpiSwiglu E{(bf16*)(ws + WS_HID)};
      pg8::gemm_phase<pg8::EpiSwiglu, pg8::StaticOrder>(F.lds, g, SO, E, F.wave);
      if (DBL_MASK & 64) pg8::gemm_phase<pg8::EpiSwiglu, pg8::StaticOrder>(F.lds, g, SO, E, F.wave); }
    GRID_BAR();
    PROBE_EXIT(17);
    { pg8::Gemm g{(const bf16*)(ws + WS_HID), (const bf16*)(ws + WS_WFD), M, DM, DFF, DFF, 0, 0}; SO.init(M, DM, F.G, F.bid);
      pg8::EpiPlain E{B3, DM};
      pg8::gemm_phase<pg8::EpiPlain, pg8::StaticOrder>(F.lds, g, SO, E, F.wave); }
    GRID_BAR();
    PROBE_EXIT(18);
    { FRESH(); for (int m = gw; m < M; m += NGW) resid_row(p.out + (size_t)m * DM, B3 + (size_t)m * DM, KARG_IN(I_FFPOST), p.out + (size_t)m * DM, nullptr, nullptr, F.lane); }
#if NAN_SCRUB
    GRID_BAR();
    { const int gt = F.bid * NTHR + F.wave * 64 + fresh_lane(), NT = F.G * NTHR; for (int i = gt; i < M * DM; i += NT) { const float v = p.out[i]; if (!(fabsf(v) < 1e30f)) p.out[i] = 0.f; } }
#endif
}

extern "C" void kernel_launch(void* const* d_in, const int* in_sizes, int n_in, void* d_out, int out_size, void* d_ws, size_t ws_size, hipStream_t stream) {
    static int grid = 0;
    if (grid == 0) {
        if (n_in != 28 || out_size != M * DM || ws_size < WS_END) { fprintf(stderr, "kernel_launch: unexpected shapes (n_in %d out %d ws %zu)\n", n_in, out_size, ws_size); grid = -1; return; }
        int dev = 0, cus = 0;
        if (hipGetDevice(&dev) != hipSuccess || hipDeviceGetAttribute(&cus, hipDeviceAttributeMultiprocessorCount, dev) != hipSuccess) { grid = -1; return; }
        if (hipFuncSetAttribute((const void*)fwd_kernel, hipFuncAttributeMaxDynamicSharedMemorySize, LDS_BYTES) != hipSuccess) { fprintf(stderr, "kernel_launch: hipFuncSetAttribute failed\n"); grid = -1; return; }
        int per_cu = 0;
        if (hipOccupancyMaxActiveBlocksPerMultiprocessor(&per_cu, (const void*)fwd_kernel, NTHR, LDS_BYTES) != hipSuccess || per_cu < 1) fprintf(stderr, "kernel_launch: occupancy query says %d\n", per_cu);
        (void)hipGetLastError();
        grid = cus;
    }
    if (grid < 0) return;
    (void)in_sizes;
    hipMemsetAsync((char*)d_ws + WS_CTL, 0, CTL_ZERO_BYTES, stream);
    Params p{};
    for (int i = 0; i < 28; ++i) p.in[i] = (const float*)d_in[i];
    p.out = (float*)d_out; p.ws = (unsigned char*)d_ws;
    hipLaunchKernelGGL(fwd_kernel, dim3(grid), dim3(NTHR), LDS_BYTES, stream, p);
}
```

```cpp
#include <hip/hip_runtime.h>
#include <cstdio>
#include <cstdint>

#define GAS __attribute__((address_space(1)))
#define LAS __attribute__((address_space(3)))
typedef unsigned short bf16;
typedef unsigned short u16;
typedef short bf16x8 __attribute__((ext_vector_type(8)));
typedef short bf16x4 __attribute__((ext_vector_type(4)));
typedef float f32x4 __attribute__((ext_vector_type(4)));
typedef float f32x16 __attribute__((ext_vector_type(16)));
typedef float f32x2 __attribute__((ext_vector_type(2)));
typedef unsigned u32x4 __attribute__((ext_vector_type(4)));
typedef unsigned u32x2 __attribute__((ext_vector_type(2)));
typedef short v4i16_t __attribute__((ext_vector_type(4)));
typedef _Float16 f16;

#define G2_XSYNC 0
constexpr int DM = 2048, NB = 2, SEQ = 8192, M = NB * SEQ, CHUNK = 64, NCH = SEQ / CHUNK;
constexpr int NMEM = 256, GH = 4, GDK = 256, GDV = 512, GRANK = 16;
constexpr int DH = 16, DDH = 128, DLAT = 256, IH = 16, IDIM = 128, TOPK = 256;
constexpr int XH = 4, XDH = 512, DFF = 5632, INCOLS = 14752;
constexpr float EPS = 1e-6f;
constexpr int NWAVES = 8, NTHR = 512;

constexpr size_t MiB = 1u << 20;
constexpr size_t WS_CTL = 0, CTL_ZERO_BYTES = 1 * MiB;
constexpr size_t WS_BTUK = 1 * MiB;
constexpr size_t WS_BTUV = 3 * MiB;
constexpr size_t WS_MEMN = 5 * MiB;
constexpr size_t WS_CLAT = 7 * MiB;
constexpr size_t WS_KIDX = 15 * MiB;
constexpr size_t WS_IDX = 19 * MiB;
constexpr size_t WS_DCRAW = 27 * MiB;
constexpr size_t WS_MISC = 43 * MiB;
constexpr size_t WS_KV = 122 * MiB;
constexpr size_t WS_VT = 126 * MiB;
constexpr size_t WS_WXKV0 = 448 * MiB;
constexpr size_t WS_S1 = 64 * MiB, WS_S2 = 128 * MiB, WS_S3 = 192 * MiB, WS_S4 = 256 * MiB, WS_S5 = 320 * MiB, WS_S6 = 384 * MiB, WS_S7 = 448 * MiB, WS_END = 512 * MiB;
constexpr size_t WS_W1A = WS_S1;
constexpr size_t WS_W1B = WS_S1 + 18 * MiB;
constexpr size_t WS_SC = WS_S1;
constexpr size_t WS_WGB = WS_S1 + 8 * MiB, WS_WDB = WS_S1 + 16 * MiB, WS_WMIX = WS_S1 + 24 * MiB;
constexpr size_t WS_U0 = WS_S2;
constexpr size_t WS_QFP = WS_S2, WS_KDT = WS_S2 + 32 * MiB;
constexpr size_t WS_IQ = WS_S3;
constexpr size_t WS_DQ = WS_S4;
constexpr size_t WS_SCR = WS_S5;
constexpr size_t WS_GR = WS_S5, WS_GVT = WS_S6;
constexpr size_t WS_WXQ = WS_S6, WS_WXKV = WS_S6 + 8 * MiB, WS_WXO = WS_S6 + 24 * MiB;
constexpr size_t WS_YDSA = WS_S7;
constexpr size_t WS_WFGU = WS_S4;
constexpr size_t WS_WFD = WS_S4 + 44 * MiB;
constexpr size_t WS_HID = 328 * MiB;
static_assert(WS_HID + (size_t)M * DFF * 2 <= WS_END && WS_MISC + 16 * MiB <= 64 * MiB && WS_DCRAW + 16 * MiB <= WS_MISC && WS_IDX + 8 * MiB <= WS_DCRAW && WS_KIDX + 4 * MiB <= WS_IDX && WS_CLAT + 8 * MiB <= WS_KIDX, "ws map");
constexpr int CW_TMO = 0, CW_BAR = 4096;

constexpr int LDS_BYTES = 163840, MISC_OFF = LDS_BYTES - 256;

#define RLX_AGENT __ATOMIC_RELAXED, __HIP_MEMORY_SCOPE_AGENT
#define LDS_WAIT() asm volatile("s_waitcnt lgkmcnt(0)" ::: "memory")
#define VM_WAIT() asm volatile("s_waitcnt vmcnt(0)" ::: "memory")
typedef __bf16 bf16x2_t __attribute__((ext_vector_type(2)));
__device__ __forceinline__ unsigned cvt_pk_bf16(float lo, float hi) { const f32x2 v = {lo, hi}; const bf16x2_t b = __builtin_convertvector(v, bf16x2_t); return __builtin_bit_cast(unsigned, b); }
__device__ __forceinline__ float bf_lo(unsigned w) { return __uint_as_float(w << 16); }
__device__ __forceinline__ float bf_hi(unsigned w) { return __uint_as_float(w & 0xffff0000u); }
__device__ __forceinline__ float bf2f(bf16 h) { return __uint_as_float((unsigned)h << 16); }
__device__ __forceinline__ float sigmoidf_(float x) { return __frcp_rn(1.0f + __expf(-x)); }
__device__ __forceinline__ int fresh_lane() { unsigned z; asm volatile("v_mov_b32 %0, 0" : "=v"(z)); return (int)__builtin_amdgcn_mbcnt_hi(~0u, __builtin_amdgcn_mbcnt_lo(~0u, z)); }
template <int O> __device__ __forceinline__ float swz_(float v) { return __int_as_float(__builtin_amdgcn_ds_swizzle(__float_as_int(v), (O << 10) | 0x1F)); }
__device__ __forceinline__ float x32_sum(float v) { const auto r = __builtin_amdgcn_permlane32_swap(__float_as_uint(v), __float_as_uint(v), false, false); return __uint_as_float(r[0]) + __uint_as_float(r[1]); }
__device__ __forceinline__ float x32_max(float v) { const auto r = __builtin_amdgcn_permlane32_swap(__float_as_uint(v), __float_as_uint(v), false, false); return fmaxf(__uint_as_float(r[0]), __uint_as_float(r[1])); }
__device__ __forceinline__ float x16_sum(float v) { return v + swz_<16>(v); }
__device__ __forceinline__ float x16_max(float v) { return fmaxf(v, swz_<16>(v)); }
__device__ __forceinline__ float wave_sum(float v) {
    v += swz_<1>(v); v += swz_<2>(v); v += swz_<4>(v); v += swz_<8>(v); v += swz_<16>(v); return x32_sum(v);
}

namespace pg8 {
typedef unsigned short bf16_t;
constexpr int BM = 256, BK = 64, HALF = 128, HTB = HALF * BK * 2, STAGE_BYTES = 8 * HTB, NXCD = 8, WGM = 8;
__host__ __device__ __forceinline__ int lds_byte(int r, int c) { const int st = (r >> 4) * 2 + (c >> 5), rr = r & 15, cc = c & 31, ob = rr * 64 + cc * 2; return st * 1024 + (ob ^ (((ob >> 9) & 1) << 5)); }
__host__ __device__ __forceinline__ void stage_rc(int b, int& R, int& C) { const int st = b / 1024, sb = b % 1024, swz = sb ^ (((sb >> 9) & 1) << 5); R = (st >> 1) * 16 + swz / 64; C = (st & 1) * 32 + (swz % 64) / 2; }
__host__ __device__ __forceinline__ int perm32(int rho) { const int n = rho >> 4, i = rho & 15; return 8 * (i >> 2) + 4 * n + (i & 3); }

struct Unit { int pm, pn; };
struct Gemm { const bf16_t* A; const bf16_t* Bt; int M, N, K, lda, acs, ash; };

struct StaticOrder {
    int nM, nN, nwg, G, c;
    __host__ __device__ void init(int M_, int N_, int G_, int c_) { nM = M_ / BM; nN = N_ / BM; nwg = nM * nN; G = G_; c = c_; }
    __host__ __device__ bool next(int i, Unit& u) const {
        const long L = (long)i * G + c; if (L >= nwg) return false;
        int wgid = (int)L; { const int q = nwg / NXCD, r = nwg % NXCD, xcd = wgid % NXCD, off = wgid / NXCD; wgid = (xcd < r ? xcd * (q + 1) : r * (q + 1) + (xcd - r) * q) + off; }
        const int nig = WGM * nN, gid = wgid / nig, fm = gid * WGM, gsz = (nM - fm) < WGM ? (nM - fm) : WGM;
        u.pm = fm + ((wgid % nig) % gsz); u.pn = (wgid % nig) / gsz; return true;
    }
};

template <class Epi, class Sched, bool ALIGN_EPI = true>
__device__ __forceinline__ void gemm_phase(LAS unsigned char* lds, const Gemm g, const Sched& S, const Epi& E, const int wid) {
    const int lane = fresh_lane(), tid = wid * 64 + lane, wr = wid >> 2, wc = wid & 3, fr = lane & 15, fq = lane >> 4;
    const int K = g.K, nt = K / BK, lda = g.lda;
    unsigned voffA[2], voffB[2];
#pragma unroll
    for (int i = 0; i < 2; ++i) { int R, C; stage_rc(tid * 16 + i * 8192, R, C); const int Rb = (R & ~31) + perm32(R & 31);
        voffA[i] = (unsigned)(R * lda + C) * 2u; voffB[i] = (unsigned)(Rb * K + C) * 2u; }
    const size_t kstep = (size_t)(BK * 2);
    const size_t hstepA = (size_t)HALF * lda * 2, hstepB = (size_t)HALF * K * 2;
    const size_t tstepA = 2 * hstepA, tstepB = 2 * hstepB;
    const unsigned ldsw = (unsigned)wid * 1024u;
    const int aoff = lds_byte(wr * 64 + fr, fq * 8), boff = lds_byte(wc * 32 + fr, fq * 8);
#define PG8_SA(b, h) (((b) * 2 + (h)) * HTB)
#define PG8_SB(b, h) ((4 + (b) * 2 + (h)) * HTB)
#define PG8_STAGE(bufoff, gbase, voff) do { _Pragma("unroll") for (int _i = 0; _i < 2; ++_i) \
        __builtin_amdgcn_global_load_lds((const unsigned*)((const char*)(gbase) + (voff)[_i]), (LAS unsigned*)(lds + (bufoff) + ldsw + _i * 8192), 16, 0, 0); } while (0)
#define PG8_LDA(dst, b, h) do { _Pragma("unroll") for (int m = 0; m < 4; ++m) _Pragma("unroll") for (int k = 0; k < 2; ++k) dst[m][k] = *(const LAS bf16x8*)(lds + PG8_SA(b, h) + aoff + m * 2048 + k * 1024); } while (0)
#define PG8_LDB(dst, b, h) do { _Pragma("unroll") for (int n = 0; n < 2; ++n) _Pragma("unroll") for (int k = 0; k < 2; ++k) dst[n][k] = *(const LAS bf16x8*)(lds + PG8_SB(b, h) + boff + n * 2048 + k * 1024); } while (0)
#define PG8_MMA(ai, bj, At, Bt) do { __builtin_amdgcn_s_setprio(1); _Pragma("unroll") for (int m = 0; m < 4; ++m) _Pragma("unroll") for (int n = 0; n < 2; ++n) _Pragma("unroll") for (int k = 0; k < 2; ++k) \
        acc[ai][bj][m][n] = __builtin_amdgcn_mfma_f32_16x16x32_bf16(Bt[n][k], At[m][k], acc[ai][bj][m][n], 0, 0, 0); __builtin_amdgcn_s_setprio(0); } while (0)
#define PG8_WAIT_V(n) asm volatile("s_waitcnt vmcnt(" #n ")" ::: "memory")
#define PG8_WAIT_L(n) asm volatile("s_waitcnt lgkmcnt(" #n ")" ::: "memory")
#define PG8_BAR __builtin_amdgcn_s_barrier()
#define PG8_SCHED __builtin_amdgcn_sched_barrier(0)
    Unit cur, nxt; int ui = 0;
    if (!S.next(0, cur)) return;
    f32x4 acc[2][2][4][2];
#pragma unroll
    for (int a = 0; a < 2; ++a)
#pragma unroll
        for (int b = 0; b < 2; ++b)
#pragma unroll
            for (int m = 0; m < 4; ++m)
#pragma unroll
                for (int n = 0; n < 2; ++n) acc[a][b][m][n] = (f32x4){0.f, 0.f, 0.f, 0.f};
    bf16x8 At[4][2], B0[2][2], B1[2][2];
    const char* cA = (const char*)g.A + (size_t)cur.pm * tstepA + (size_t)((cur.pn >> g.ash) * g.acs) * 2; const char* cB = (const char*)g.Bt + (size_t)cur.pn * tstepB;
    PG8_STAGE(PG8_SB(0, 0), cB, voffB); PG8_STAGE(PG8_SB(0, 1), cB + hstepB, voffB); PG8_STAGE(PG8_SA(0, 0), cA, voffA); PG8_STAGE(PG8_SA(0, 1), cA + hstepA, voffA);
    if (wr == 1) PG8_BAR;
    PG8_WAIT_V(2); PG8_BAR;
    PG8_STAGE(PG8_SB(1, 0), cB + kstep, voffB); PG8_STAGE(PG8_SA(1, 0), cA + kstep, voffA); PG8_STAGE(PG8_SB(1, 1), cB + hstepB + kstep, voffB);
    PG8_WAIT_V(6); PG8_BAR;
    for (;;) {
        const bool has_next = S.next(ui + 1, nxt);
        const char* nA = has_next ? (const char*)g.A + (size_t)nxt.pm * tstepA + (size_t)((nxt.pn >> g.ash) * g.acs) * 2 : cA; const char* nB = has_next ? (const char*)g.Bt + (size_t)nxt.pn * tstepB : cB;
#pragma unroll 1
        for (int t = 0; t < nt; t += 2) {
            const bool last = (t == nt - 2);
            const char* a1 = cA + (size_t)(t + 1) * kstep;
            const char* a2 = last ? nA : cA + (size_t)(t + 2) * kstep; const char* b2 = last ? nB : cB + (size_t)(t + 2) * kstep;
            const char* a3 = a2 + kstep; const char* b3 = b2 + kstep;
            PG8_LDB(B0, 0, 0); PG8_LDB(B1, 0, 1); PG8_SCHED; PG8_LDA(At, 0, 0); PG8_STAGE(PG8_SA(1, 1), a1 + hstepA, voffA);
            PG8_WAIT_V(8); PG8_WAIT_L(0); PG8_BAR; PG8_MMA(0, 0, At, B0); PG8_MMA(0, 1, At, B1); PG8_BAR; PG8_SCHED;
            PG8_LDA(At, 0, 1); PG8_STAGE(PG8_SB(0, 0), b2, voffB); PG8_STAGE(PG8_SB(0, 1), b2 + hstepB, voffB); PG8_STAGE(PG8_SA(0, 0), a2, voffA);
            PG8_WAIT_V(8); PG8_WAIT_L(0); PG8_BAR; PG8_MMA(1, 0, At, B0); PG8_MMA(1, 1, At, B1); PG8_BAR; PG8_SCHED;
            PG8_LDB(B0, 1, 0); PG8_LDB(B1, 1, 1); PG8_SCHED; PG8_LDA(At, 1, 0); PG8_STAGE(PG8_SA(0, 1), a2 + hstepA, voffA);
            PG8_WAIT_V(8); PG8_WAIT_L(0); PG8_BAR; PG8_MMA(0, 0, At, B0); PG8_MMA(0, 1, At, B1); PG8_BAR; PG8_SCHED;
            PG8_LDA(At, 1, 1); PG8_STAGE(PG8_SB(1, 0), b3, voffB); PG8_STAGE(PG8_SB(1, 1), b3 + hstepB, voffB); PG8_STAGE(PG8_SA(1, 0), a3, voffA);
            PG8_WAIT_V(8); PG8_WAIT_L(0); PG8_BAR; PG8_MMA(1, 0, At, B0); PG8_MMA(1, 1, At, B1); PG8_BAR; PG8_SCHED;
        }
        if constexpr (ALIGN_EPI) { if (wr == 0) PG8_BAR; }
        E(acc, cur, wr, wc, fr, fq);
        if (!has_next) break;
#pragma unroll
        for (int a = 0; a < 2; ++a)
#pragma unroll
            for (int b = 0; b < 2; ++b)
#pragma unroll
                for (int m = 0; m < 4; ++m)
#pragma unroll
                    for (int n = 0; n < 2; ++n) acc[a][b][m][n] = (f32x4){0.f, 0.f, 0.f, 0.f};
        cur = nxt; cA = nA; cB = nB; ++ui;
        if constexpr (ALIGN_EPI) { if (wr == 1) PG8_BAR; }
    }
    PG8_WAIT_V(0);
    if constexpr (!ALIGN_EPI) { if (wr == 0) PG8_BAR; }
    PG8_BAR;
#undef PG8_SA
#undef PG8_SB
#undef PG8_STAGE
#undef PG8_LDA
#undef PG8_LDB
#undef PG8_MMA
#undef PG8_WAIT_V
#undef PG8_WAIT_L
#undef PG8_BAR
#undef PG8_SCHED
}

#define EPI_LOOP_BEGIN const int row0 = u.pm * BM + wr * 64 + fr; const int cl = wc * 32 + 8 * fq; \
    _Pragma("unroll") for (int ai = 0; ai < 2; ++ai) _Pragma("unroll") for (int m = 0; m < 4; ++m) { const size_t row = (size_t)(row0 + ai * HALF + m * 16);
#define EPI_LOOP_END }
__device__ __forceinline__ u32x4 pack8(const f32x4 v0, const f32x4 v1) { u32x4 w; w.x = cvt_pk_bf16(v0[0], v0[1]); w.y = cvt_pk_bf16(v0[2], v0[3]); w.z = cvt_pk_bf16(v1[0], v1[1]); w.w = cvt_pk_bf16(v1[2], v1[3]); return w; }

struct EpiPlain {
    bf16_t* O; int ldc;
    __device__ __forceinline__ void operator()(const f32x4 (&acc)[2][2][4][2], const Unit& u, int wr, int wc, int fr, int fq) const {
        EPI_LOOP_BEGIN
            bf16_t* rp = O + row * ldc + u.pn * BM + cl;
#pragma unroll
            for (int bj = 0; bj < 2; ++bj) *(u32x4*)(rp + bj * HALF) = pack8(acc[ai][bj][m][0], acc[ai][bj][m][1]);
        EPI_LOOP_END
    }
};
struct EpiP1a {
    bf16_t* iq; bf16_t* dq; float* dc; float* misc;
    __device__ __forceinline__ void operator()(const f32x4 (&acc)[2][2][4][2], const Unit& u, int wr, int wc, int fr, int fq) const {
        if (u.pn < 16) {
            bf16_t* base = (u.pn < 8) ? iq : dq; const int ct = (u.pn & 7) * BM;
            EPI_LOOP_BEGIN
                bf16_t* rp = base + row * DM + ct + cl;
#pragma unroll
                for (int bj = 0; bj < 2; ++bj) *(u32x4*)(rp + bj * HALF) = pack8(acc[ai][bj][m][0], acc[ai][bj][m][1]);
            EPI_LOOP_END
        } else {
            float* base = (u.pn == 16) ? dc : misc;
            EPI_LOOP_BEGIN
                float* rp = base + row * 256 + cl;
#pragma unroll
                for (int bj = 0; bj < 2; ++bj) { *(f32x4*)(rp + bj * HALF) = acc[ai][bj][m][0]; *(f32x4*)(rp + bj * HALF + 4) = acc[ai][bj][m][1]; }
            EPI_LOOP_END
        }
    }
};
struct EpiP1b {
    bf16_t* gqk; bf16_t* gv; bf16_t* gr; bf16_t* sg; bf16_t* sd;
    __device__ __forceinline__ void operator()(const f32x4 (&acc)[2][2][4][2], const Unit& u, int wr, int wc, int fr, int fq) const {
        const int seg = u.pn >> 3; const int ct = (u.pn & 7) * BM;
        bf16_t* base = seg == 0 ? gqk : seg == 1 ? gv : seg == 2 ? gr : seg == 3 ? sg : sd;
        const bool sig = seg >= 3;
        EPI_LOOP_BEGIN
            bf16_t* rp = base + row * DM + ct + cl;
#pragma unroll
            for (int bj = 0; bj < 2; ++bj) { f32x4 v0 = acc[ai][bj][m][0], v1 = acc[ai][bj][m][1];
                if (sig) {
#pragma unroll
                    for (int e = 0; e < 4; ++e) { v0[e] = sigmoidf_(v0[e]); v1[e] = sigmoidf_(v1[e]); } }
                *(u32x4*)(rp + bj * HALF) = pack8(v0, v1); }
        EPI_LOOP_END
    }
};
struct EpiGateMul {
    bf16_t* Gt;
    __device__ __forceinline__ void operator()(const f32x4 (&acc)[2][2][4][2], const Unit& u, int wr, int wc, int fr, int fq) const {
        EPI_LOOP_BEGIN
            bf16_t* rp = Gt + row * DM + u.pn * BM + cl;
#pragma unroll
            for (int bj = 0; bj < 2; ++bj) { const u32x4 gg = *(const u32x4*)(rp + bj * HALF); f32x4 v0 = acc[ai][bj][m][0], v1 = acc[ai][bj][m][1];
                v0[0] *= bf_lo(gg.x); v0[1] *= bf_hi(gg.x); v0[2] *= bf_lo(gg.y); v0[3] *= bf_hi(gg.y); v1[0] *= bf_lo(gg.z); v1[1] *= bf_hi(gg.z); v1[2] *= bf_lo(gg.w); v1[3] *= bf_hi(gg.w);
                *(u32x4*)(rp + bj * HALF) = pack8(v0, v1); }
        EPI_LOOP_END
    }
};
struct EpiMerge {
    const bf16_t* SG; const bf16_t* T; bf16_t* O;
    __device__ __forceinline__ void operator()(const f32x4 (&acc)[2][2][4][2], const Unit& u, int wr, int wc, int fr, int fq) const {
        EPI_LOOP_BEGIN
            const size_t o = row * DM + u.pn * BM + cl;
#pragma unroll
            for (int bj = 0; bj < 2; ++bj) { const u32x4 gg = *(const u32x4*)(SG + o + bj * HALF); const u32x4 tt = *(const u32x4*)(T + o + bj * HALF); f32x4 v0 = acc[ai][bj][m][0], v1 = acc[ai][bj][m][1];
                v0[0] = v0[0] * bf_lo(gg.x) + bf_lo(tt.x); v0[1] = v0[1] * bf_hi(gg.x) + bf_hi(tt.x); v0[2] = v0[2] * bf_lo(gg.y) + bf_lo(tt.y); v0[3] = v0[3] * bf_hi(gg.y) + bf_hi(tt.y);
                v1[0] = v1[0] * bf_lo(gg.z) + bf_lo(tt.z); v1[1] = v1[1] * bf_hi(gg.z) + bf_hi(tt.z); v1[2] = v1[2] * bf_lo(gg.w) + bf_lo(tt.w); v1[3] = v1[3] * bf_hi(gg.w) + bf_hi(tt.w);
                *(u32x4*)(O + o + bj * HALF) = pack8(v0, v1); }
        EPI_LOOP_END
    }
};
struct EpiSwiglu {
    bf16_t* H;
    __device__ __forceinline__ void operator()(const f32x4 (&acc)[2][2][4][2], const Unit& u, int wr, int wc, int fr, int fq) const {
        EPI_LOOP_BEGIN
            f32x4 v0, v1;
#pragma unroll
            for (int e = 0; e < 4; ++e) { const float g0 = acc[ai][0][m][0][e], g1 = acc[ai][0][m][1][e];
                v0[e] = g0 * sigmoidf_(g0) * acc[ai][1][m][0][e]; v1[e] = g1 * sigmoidf_(g1) * acc[ai][1][m][1][e]; }
            *(u32x4*)(H + row * DFF + u.pn * HALF + cl) = pack8(v0, v1);
        EPI_LOOP_END
    }
};
}

#define XB_TMO      128
#define XB_XCNT(j)  (256  + 64 * (j))
#define XB_XSUB(j)  (1280 + 64 * (j))
#define XB_XGEN(j)  (2304 + 64 * (j))
#define XB_TOP      3328
#define XB_TOPGEN   3392
#define XCD_BAR_WORDS 3456
#define XB_SPIN_CAP (1u << 22)
__device__ __forceinline__ unsigned xb_ld(unsigned* p)              { return __hip_atomic_load(p, __ATOMIC_RELAXED, __HIP_MEMORY_SCOPE_AGENT); }
__device__ __forceinline__ unsigned xb_add(unsigned* p, unsigned v) { return __hip_atomic_fetch_add(p, v, __ATOMIC_RELAXED, __HIP_MEMORY_SCOPE_AGENT); }
__device__ __forceinline__ unsigned xb_xcc_id() { return (unsigned)__builtin_amdgcn_s_getreg((3 << 11) | 20) & 0xFu; }
#define XB_SPIN(cond, bar) do { unsigned _sp = 0; while (cond) { __builtin_amdgcn_s_sleep(1); \
    if ((++_sp & 255u) == 0u) { if (xb_ld(&(bar)[XB_TMO])) break; if (_sp > XB_SPIN_CAP) { atomicAdd(&(bar)[XB_TMO], 1u); break; } } } } while (0)
struct XcdBarrier { unsigned* bar; unsigned x; volatile LAS unsigned* st; int wave; };
__device__ __forceinline__ bool xb_thread0(int wave) { return wave == 0 && fresh_lane() == 0; }
__device__ __forceinline__ XcdBarrier xcd_barrier_post(unsigned* bar, volatile LAS unsigned* st, int wave) {
    XcdBarrier b; b.bar = bar; b.x = xb_xcc_id(); b.st = st; b.wave = wave;
    if (xb_thread0(b.wave)) (void)xb_add(&bar[XB_XCNT(b.x)], 1u);
    return b;
}
__device__ __forceinline__ void xcd_barrier_complete(unsigned* bar, unsigned x, unsigned& nloc, unsigned& nx) {
    const unsigned G = gridDim.x * gridDim.y * gridDim.z;
    unsigned sum, cnt, mine, sp = 0u;
    for (;;) {
        sum = 0u; cnt = 0u; mine = 0u;
#pragma unroll
        for (unsigned j = 0; j < 16; ++j) { const unsigned c = xb_ld(&bar[XB_XCNT(j)]); sum += c; cnt += (c > 0u) ? 1u : 0u; mine = (j == x) ? c : mine; }
        if (sum == G) break;
        __builtin_amdgcn_s_sleep(1);
        if ((++sp & 255u) == 0u) { if (xb_ld(&bar[XB_TMO])) break; if (sp > XB_SPIN_CAP) { atomicAdd(&bar[XB_TMO], 1u); break; } }
    }
    nloc = mine > 0u ? mine : 1u; nx = cnt > 0u ? cnt : 1u;
}
#ifndef BAR_SCOPE
#define BAR_SCOPE "agent"
#endif
__device__ __forceinline__ void xcd_barrier(const XcdBarrier& b) {
    asm volatile("s_waitcnt vmcnt(0)" ::: "memory");
    __syncthreads();
    if (xb_thread0(b.wave)) {
        unsigned* bar = b.bar;
        __builtin_amdgcn_s_waitcnt(0);
        unsigned nloc = b.st[0], nx = b.st[1];
        if (nloc == 0u) { xcd_barrier_complete(bar, b.x, nloc, nx); b.st[0] = nloc; b.st[1] = nx; }
        const unsigned old = xb_add(&bar[XB_XSUB(b.x)], 1u);
        const unsigned gen = old / nloc;
        if (old + 1u == (gen + 1u) * nloc) {
            __builtin_amdgcn_fence(__ATOMIC_RELEASE, BAR_SCOPE);
            asm volatile("s_waitcnt vmcnt(0)" ::: "memory");
            const unsigned og = xb_add(&bar[XB_TOP], 1u);
            const unsigned tg = og / nx;
            if (og + 1u == (tg + 1u) * nx) xb_add(&bar[XB_TOPGEN], 1u);
            else XB_SPIN(xb_ld(&bar[XB_TOPGEN]) == tg, bar);
            __builtin_amdgcn_fence(__ATOMIC_ACQUIRE, BAR_SCOPE);
            xb_add(&bar[XB_XGEN(b.x)], 1u);
            asm volatile("s_waitcnt vmcnt(0)" ::: "memory");
        } else {
            XB_SPIN(xb_ld(&bar[XB_XGEN(b.x)]) == gen, bar);
            __builtin_amdgcn_fence(__ATOMIC_ACQUIRE, BAR_SCOPE);
            asm volatile("s_waitcnt vmcnt(0)" ::: "memory");
        }
    }
    __syncthreads();
}

struct Params { const float* in[28]; float* out; unsigned char* ws; };
#define KARG_IN(i) (*(const float* const volatile __attribute__((address_space(4)))*)((const __attribute__((address_space(4))) char*)__builtin_amdgcn_kernarg_segment_ptr() + 8 * (i)))

enum { I_X = 0, I_MEM, I_WIN, I_WA2, I_BA, I_GONORM, I_WUK, I_WUV, I_LATNORM, I_IKW, I_IKB, I_RELB, I_WGB, I_WDB, I_WMIX, I_MIXPRE, I_MIXPOST, I_XAPRE, I_XAPOST, I_XAMEM,
       I_WXQ, I_WXKV, I_WXO, I_FFPRE, I_FFPOST, I_WFG, I_WFU, I_WFD };

__device__ __forceinline__ void conv_item(const float* W, int ldw, int c0, int ncols, bf16* dst, int dk, int koff, int r0, LAS float* scr, int item, int lane) {
    const int nblk = (ncols + 63) >> 6, kb = item / nblk, nb = item - kb * nblk, k0 = 64 * kb, n0 = 64 * nb, nv = ncols - n0;
    const int c4 = lane & 15, r = lane >> 4;
    LAS unsigned char* t = (LAS unsigned char*)scr;
    f32x4 v[16];
    const float* src = W + (size_t)(k0 + 16 * r) * ldw + c0 + n0 + 4 * c4;
    if (4 * c4 < nv) {
#pragma unroll
        for (int i = 0; i < 16; ++i) v[i] = *(const f32x4*)(src + (size_t)i * ldw);
    } else {
#pragma unroll
        for (int i = 0; i < 16; ++i) v[i] = (f32x4){0.f, 0.f, 0.f, 0.f};
    }
#pragma unroll
    for (int e = 0; e < 4; ++e) {
        u32x4 a, b;
        a.x = cvt_pk_bf16(v[0][e], v[1][e]); a.y = cvt_pk_bf16(v[2][e], v[3][e]); a.z = cvt_pk_bf16(v[4][e], v[5][e]); a.w = cvt_pk_bf16(v[6][e], v[7][e]);
        b.x = cvt_pk_bf16(v[8][e], v[9][e]); b.y = cvt_pk_bf16(v[10][e], v[11][e]); b.z = cvt_pk_bf16(v[12][e], v[13][e]); b.w = cvt_pk_bf16(v[14][e], v[15][e]);
        *(LAS u32x4*)(t + (4 * c4 + e) * 144 + r * 32) = a; *(LAS u32x4*)(t + (4 * c4 + e) * 144 + r * 32 + 16) = b;
    }
    LDS_WAIT();
    const int ch = lane & 7;
#pragma unroll
    for (int j = 0; j < 8; ++j) { const int n = (lane >> 3) + 8 * j; const u32x4 o = *(const LAS u32x4*)(t + n * 144 + ch * 16);
        if (n < nv) *(GAS u32x4*)(dst + (size_t)(r0 + n0 + n) * dk + koff + k0 + 8 * ch) = o; }
    LDS_WAIT();
}
__device__ __forceinline__ void conv_seg(const float* W, int ldw, int K, int c0, int ncols, bf16* dst, int dk, int koff, int r0, LAS float* scr, int gw, int NGW, int lane, int& rot) {
    const int items = (K >> 6) * ((ncols + 63) >> 6);
    int st = gw - rot; if (st < 0) st += NGW;
    for (int it = st; it < items; it += NGW) conv_item(W, ldw, c0, ncols, dst, dk, koff, r0, scr, it, lane);
    rot = (rot + items) % NGW;
}

__device__ __forceinline__ void rms_row_to_bf16(const float* xrow, const float* gain, bf16* orow, int lane) {
    const f32x4* xr = (const f32x4*)xrow + lane; const f32x4* gr = (const f32x4*)gain + lane;
    f32x4 v[8]; float s = 0.f;
#pragma unroll
    for (int j = 0; j < 8; ++j) { v[j] = xr[64 * j]; s += (v[j].x * v[j].x + v[j].y * v[j].y) + (v[j].z * v[j].z + v[j].w * v[j].w); }
    const float rstd = rsqrtf(wave_sum(s) * (1.f / DM) + EPS);
    u32x2* o8 = (u32x2*)orow + lane;
#pragma unroll
    for (int j = 0; j < 8; ++j) { const f32x4 g = gr[64 * j]; u32x2 w; w.x = cvt_pk_bf16(v[j].x * rstd * g.x, v[j].y * rstd * g.y); w.y = cvt_pk_bf16(v[j].z * rstd * g.z, v[j].w * rstd * g.w); o8[64 * j] = w; }
}
template <bool HIN_BF, bool HOUT_BF> __device__ __forceinline__ void resid_row(const void* hold, const bf16* yrow, const float* gpost, void* hout, const float* gpre, bf16* urow, int lane) {
    const u32x2* yr = (const u32x2*)yrow + lane; const f32x4* gp = (const f32x4*)gpost + lane;
    f32x4 y[8]; float s = 0.f;
#pragma unroll
    for (int j = 0; j < 8; ++j) { const u32x2 w = yr[64 * j]; y[j] = (f32x4){bf_lo(w.x), bf_hi(w.x), bf_lo(w.y), bf_hi(w.y)}; s += (y[j].x * y[j].x + y[j].y * y[j].y) + (y[j].z * y[j].z + y[j].w * y[j].w); }
    const float rstd = rsqrtf(wave_sum(s) * (1.f / DM) + EPS);
    float s2 = 0.f;
#pragma unroll
    for (int j = 0; j < 8; ++j) { f32x4 h;
        if (HIN_BF) { const u32x2 w = ((const u32x2*)hold + lane)[64 * j]; h = (f32x4){bf_lo(w.x), bf_hi(w.x), bf_lo(w.y), bf_hi(w.y)}; } else h = ((const f32x4*)hold + lane)[64 * j];
        const f32x4 g = gp[64 * j]; y[j] = h + y[j] * rstd * g; s2 += (y[j].x * y[j].x + y[j].y * y[j].y) + (y[j].z * y[j].z + y[j].w * y[j].w); }
#pragma unroll
    for (int j = 0; j < 8; ++j) {
        if (HOUT_BF) { u32x2 w; w.x = cvt_pk_bf16(y[j].x, y[j].y); w.y = cvt_pk_bf16(y[j].z, y[j].w); ((u32x2*)hout + lane)[64 * j] = w; } else ((f32x4*)hout + lane)[64 * j] = y[j]; }
    if (urow) {
        const float r2 = rsqrtf(wave_sum(s2) * (1.f / DM) + EPS); const f32x4* g2 = (const f32x4*)gpre + lane; u32x2* o8 = (u32x2*)urow + lane;
#pragma unroll
        for (int j = 0; j < 8; ++j) { const f32x4 g = g2[64 * j]; u32x2 w; w.x = cvt_pk_bf16(y[j].x * r2 * g.x, y[j].y * r2 * g.y); w.y = cvt_pk_bf16(y[j].z * r2 * g.z, y[j].w * r2 * g.w); o8[64 * j] = w; }
    }
}

struct Frame {
    LAS unsigned char* lds;
    int tid, lane, wave, bid, G;
};

__device__ __forceinline__ void p0_prologue(const Params& p, const Frame& F) {
    LAS float* scr = (LAS float*)(F.lds + F.wave * 16384);
    const int gw = F.bid * NWAVES + F.wave, NGW = F.G * NWAVES, lane = F.lane;
    unsigned char* ws = p.ws;
    const float* win = KARG_IN(I_WIN);
    int rot = 0;
    bf16* w1a = (bf16*)(ws + WS_W1A); bf16* w1b = (bf16*)(ws + WS_W1B);
    conv_seg(win, INCOLS, DM, 8464, 2048, w1a, DM, 0, 0, scr, gw, NGW, lane, rot);
    conv_seg(win, INCOLS, DM, 6160, 2048, w1a, DM, 0, 2048, scr, gw, NGW, lane, rot);
    conv_seg(win, INCOLS, DM, 8208, 256, w1a, DM, 0, 4096, scr, gw, NGW, lane, rot);
    conv_seg(win, INCOLS, DM, 10512, 128, w1a, DM, 0, 4352, scr, gw, NGW, lane, rot);
    conv_seg(win, INCOLS, DM, 10640, 16, w1a, DM, 0, 4480, scr, gw, NGW, lane, rot);
    conv_seg(win, INCOLS, DM, 6144, 16, w1a, DM, 0, 4496, scr, gw, NGW, lane, rot);
    { u32x4* z = (u32x4*)(w1a + (size_t)4512 * DM); const int nz = 96 * DM * 2 / 16; for (int i = gw * 64 + lane; i < nz; i += NGW * 64) z[i] = (u32x4){0u, 0u, 0u, 0u}; }
    { bf16* d = (bf16*)(ws + WS_BTUK); const float* s = KARG_IN(I_WUK);
      for (int i = gw * 64 + lane; i < 4096 * 256; i += NGW * 64) { const int row = i >> 8, k = i & 255, h = row >> 8, r = row & 255;
          const float v = ((k >> 7) == (h & 1)) ? s[((size_t)h * 128 + (k & 127)) * 256 + r] : 0.f; d[i] = (bf16)(cvt_pk_bf16(v, 0.f) & 0xffffu); } }
    conv_seg(KARG_IN(I_WXKV), 2 * DM, DM, 0, 2 * DM, (bf16*)(ws + WS_WXKV0), DM, 0, 0, scr, gw, NGW, lane, rot);
    { bf16* u0 = (bf16*)(ws + WS_U0); for (int m = gw; m < M; m += NGW) rms_row_to_bf16(KARG_IN(I_X) + (size_t)m * DM, KARG_IN(I_MIXPRE), u0 + (size_t)m * DM, lane); }
    { bf16* mn = (bf16*)(ws + WS_MEMN); int st = gw - rot; if (st < 0) st += NGW; for (int m = st; m < NB * NMEM; m += NGW) rms_row_to_bf16(KARG_IN(I_MEM) + (size_t)m * DM, KARG_IN(I_XAMEM), mn + (size_t)m * DM, lane); }
}

__device__ __forceinline__ void p0_late(const Params& p, const Frame& F, int gw, int NGW) {
    LAS float* scr = (LAS float*)(F.lds + F.wave * 16384);
    const int lane = F.lane;
    unsigned char* ws = p.ws;
    const float* win = KARG_IN(I_WIN);
    bf16* w1b = (bf16*)(ws + WS_W1B);
    int rot = 0;
    conv_seg(win, INCOLS, DM, 0, 6144, w1b, DM, 0, 0, scr, gw, NGW, lane, rot);
    conv_seg(win, INCOLS, DM, 10656, 4096, w1b, DM, 0, 6144, scr, gw, NGW, lane, rot);
    { bf16* d = (bf16*)(ws + WS_BTUV); const float* s = KARG_IN(I_WUV);
      for (int i = gw * 64 + lane; i < 2048 * 512; i += NGW * 64) { const int row = i >> 9, k = i & 511, hp = row >> 8, j = (row >> 7) & 1, v = row & 127;
          const float x = ((k >> 8) == j) ? s[((size_t)(2 * hp + j) * 256 + (k & 255)) * 128 + v] : 0.f; d[i] = (bf16)(cvt_pk_bf16(x, 0.f) & 0xffffu); } }
}

__device__ __forceinline__ void p2_norms(const Params& p, const Frame& F) {
    const int gw = F.bid * NWAVES + F.wave, NGW = F.G * NWAVES, lane = F.lane;
    const float* dc = (const float*)(p.ws + WS_DCRAW); const float* misc = (const float*)(p.ws + WS_MISC);
    bf16* clat = (bf16*)(p.ws + WS_CLAT); bf16* kidx = (bf16*)(p.ws + WS_KIDX);
    const f32x4 gl = ((const f32x4*)KARG_IN(I_LATNORM))[lane];
    const f32x2 kw = ((const f32x2*)KARG_IN(I_IKW))[lane], kb = ((const f32x2*)KARG_IN(I_IKB))[lane];
    for (int m = gw; m < M; m += NGW) {
        const f32x4 v = ((const f32x4*)(dc + (size_t)m * 256))[lane];
        const float ss = wave_sum((v.x * v.x + v.y * v.y) + (v.z * v.z + v.w * v.w));
        const float rstd = rsqrtf(ss * (1.f / 256.f) + EPS);
        u32x2 w; w.x = cvt_pk_bf16(v.x * rstd * gl.x, v.y * rstd * gl.y); w.y = cvt_pk_bf16(v.z * rstd * gl.z, v.w * rstd * gl.w);
        ((u32x2*)(clat + (size_t)m * 256))[lane] = w;
        const f32x2 a = ((const f32x2*)(misc + (size_t)m * 256))[lane];
        const float mu = wave_sum(a.x + a.y) * (1.f / 128.f);
        const float dx = a.x - mu, dy = a.y - mu;
        const float var = wave_sum(dx * dx + dy * dy) * (1.f / 128.f);
        const float r2 = rsqrtf(var + EPS);
        ((unsigned*)(kidx + (size_t)m * 128))[lane] = cvt_pk_bf16(dx * r2 * kw.x + kb.x, dy * r2 * kw.y + kb.y);
    }
}

constexpr int IDX_KROW = 272;
constexpr int IDX_KBUF = 64 * IDX_KROW;
__device__ __forceinline__ int wave_incl_scan(int v) {
    v += __builtin_amdgcn_update_dpp(0, v, 0x111, 0xf, 0xf, true);
    v += __builtin_amdgcn_update_dpp(0, v, 0x112, 0xf, 0xf, true);
    v += __builtin_amdgcn_update_dpp(0, v, 0x114, 0xf, 0xf, true);
    v += __builtin_amdgcn_update_dpp(0, v, 0x118, 0xf, 0xf, true);
    v += __builtin_amdgcn_update_dpp(0, v, 0x142, 0xa, 0xf, false);
    v += __builtin_amdgcn_update_dpp(0, v, 0x143, 0xc, 0xf, false);
    return v;
}
constexpr int IDX_STG_OFF = 53248, IDX_STG_W = 1024;
static_assert(3 * IDX_KBUF <= IDX_STG_OFF && IDX_STG_OFF + 8 * IDX_STG_W <= MISC_OFF, "idx lds");
#define PK_SUBSAT(D, A, B) asm("v_pk_sub_u16 %0, %1, %2 clamp" : "=v"(D) : "v"(A), "s"(B))
#define PK_MIN(D, A, B) asm("v_pk_min_u16 %0, %1, %2" : "=v"(D) : "v"(A), "s"(B))
#define PK_ADD(D, A, B) asm("v_pk_add_u16 %0, %1, %2" : "=v"(D) : "v"(A), "v"(B))
__device__ __forceinline__ void idx_select_query(const unsigned* rowp, int L, u16* outp, int lane, LAS unsigned char* stg) {
    unsigned kp[64];
    int laneB = (lane >> 3) * 64 + 4 * (lane & 7); asm volatile("" : "+v"(laneB));
    const int nblk = (L + 1023) >> 10;
    const int vt = (L >> 6) - (lane >> 3);
#pragma unroll
    for (int blk = 0; blk < 8; ++blk) {
        if (blk < nblk) {
#pragma unroll
            for (int h = 0; h < 2; ++h) { const int r4 = 2 * blk + h; const u32x4 v = *(const u32x4*)(rowp + (r4 * 64 + lane) * 4);
                kp[4 * r4 + 0] = v.x; kp[4 * r4 + 1] = v.y; kp[4 * r4 + 2] = v.z; kp[4 * r4 + 3] = v.w; }
        }
    }
    typedef short s16x2v __attribute__((ext_vector_type(2)));
#pragma unroll
    for (int blk = 0; blk < 8; ++blk) {
        if (blk < nblk) {
#pragma unroll
            for (int r = blk * 8; r < blk * 8 + 8; ++r) {
                const unsigned pb = kp[r];
                const unsigned mneg = __builtin_bit_cast(unsigned, __builtin_bit_cast(s16x2v, pb) >> (short)15);
                const unsigned k = pb ^ (mneg | 0x80008000u);
                kp[r] = ((r >> 2) * 8 < vt) ? k : 0u;
            }
        } else {
#pragma unroll
            for (int r = blk * 8; r < blk * 8 + 8; ++r) kp[r] = 0u;
        }
    }
    const unsigned one2 = 0x00010001u;
    unsigned T = 0u;
    for (int bit = 15; bit >= 0; --bit) {
        const unsigned c16v = T | (1u << bit); const unsigned cm1 = (c16v - 1u) * 0x00010001u;
        unsigned a0 = 0u, a1 = 0u;
#pragma unroll
        for (int blk = 0; blk < 8; ++blk) {
            if (blk < nblk) {
#pragma unroll
                for (int r = blk * 8; r < blk * 8 + 8; r += 2) {
                    unsigned d0, d1;
                    PK_SUBSAT(d0, kp[r], cm1); PK_MIN(d0, d0, one2); PK_ADD(a0, a0, d0);
                    PK_SUBSAT(d1, kp[r + 1], cm1); PK_MIN(d1, d1, one2); PK_ADD(a1, a1, d1);
                }
            }
        }
        unsigned ap; PK_ADD(ap, a0, a1);
        const int cnt = __builtin_amdgcn_readlane(wave_incl_scan((int)((ap & 0xFFFFu) + (ap >> 16))), 63);
        if (cnt >= TOPK) T = c16v;
    }
    const unsigned Tpk = T * 0x00010001u;
    unsigned g0 = 0u, g1 = 0u, ne[4] = {0u, 0u, 0u, 0u};
#pragma unroll
    for (int blk = 0; blk < 8; ++blk) {
        if (blk < nblk) {
#pragma unroll
            for (int r = blk * 8; r < blk * 8 + 8; r += 2) {
                unsigned d0, d1, x0, x1;
                PK_SUBSAT(d0, kp[r], Tpk); PK_MIN(d0, d0, one2); PK_ADD(g0, g0, d0);
                PK_SUBSAT(d1, kp[r + 1], Tpk); PK_MIN(d1, d1, one2); PK_ADD(g1, g1, d1);
                x0 = kp[r] ^ Tpk; PK_MIN(x0, x0, one2); ne[r >> 4] |= x0 << (r & 15);
                x1 = kp[r + 1] ^ Tpk; PK_MIN(x1, x1, one2); ne[r >> 4] |= x1 << ((r + 1) & 15);
            }
        }
    }
    unsigned gp; PK_ADD(gp, g0, g1);
    const int ngt = (int)((gp & 0xFFFFu) + (gp >> 16));
    unsigned eq[4]; int neq = 0;
#pragma unroll
    for (int j = 0; j < 4; ++j) { const unsigned pm = (nblk >= 2 * j + 2) ? 0xFFFFFFFFu : (nblk == 2 * j + 1 ? 0x00FF00FFu : 0u); eq[j] = ~ne[j] & pm; neq += __builtin_popcount(eq[j]); }
    const int sg = wave_incl_scan(ngt), se = wave_incl_scan(neq);
    const int tot_gt = __builtin_amdgcn_readlane(sg, 63);
    LAS unsigned char* dump = stg + 2 * lane;
    LAS unsigned char* og = stg + 128 + 2 * (sg - ngt);
#pragma unroll
    for (int blk = 0; blk < 8; ++blk) {
        if (blk < nblk) {
#pragma unroll
            for (int r = blk * 8; r < blk * 8 + 8; ++r) {
#pragma unroll
                for (int hlf = 0; hlf < 2; ++hlf) {
                    const unsigned kv = hlf ? (kp[r] >> 16) : (kp[r] & 0xFFFFu);
                    const u16 id = (u16)(laneB + ((r >> 2) * 512 + (r & 3) + hlf * 32));
                    const bool tk = kv > T;
                    *(LAS u16*)(tk ? og : dump) = id;
                    og += tk ? 2 : 0;
                }
            }
        }
    }
    int oe = tot_gt + se - neq;
    while (true) {
        const unsigned any = eq[0] | eq[1] | eq[2] | eq[3];
        if (__builtin_amdgcn_ballot_w64(any != 0u) == 0ull) break;
        const int j = eq[0] ? 0 : (eq[1] ? 1 : (eq[2] ? 2 : 3));
        const unsigned m = eq[0] ? eq[0] : (eq[1] ? eq[1] : (eq[2] ? eq[2] : eq[3]));
        const int b = m ? __builtin_ctz(m) : 0;
        const int r = 16 * j + (b & 15);
        const u16 id = (u16)(laneB + ((r >> 2) * 512 + (r & 3) + (b >> 4) * 32));
        const bool tk = (any != 0u) && (oe < TOPK);
        *(LAS u16*)(tk ? (stg + 128 + 2 * oe) : dump) = id;
        oe += (any != 0u) ? 1 : 0;
        const unsigned clr = ~(m & (0u - m));
        if (j == 0) eq[0] &= clr; else if (j == 1) eq[1] &= clr; else if (j == 2) eq[2] &= clr; else eq[3] &= clr;
    }
    LDS_WAIT();
    const u32x2 ov = *(const LAS u32x2*)(stg + 128 + 8 * lane);
    *(u32x2*)(outp + 4 * lane) = ov;
}

#ifndef SC_VAR
#define SC_VAR -1
#endif
#ifndef TP_REGION
#define TP_REGION 0
#endif
#define TPR_BEGIN(ID) unsigned long long tpr0_ = 0; if (TP_REGION == (ID)) tpr0_ = __builtin_amdgcn_s_memrealtime()
#define TPR_END(ID) do { if (TP_REGION == (ID) && F.wave == 0 && fresh_lane() == 0) { LAS unsigned* M_ = (LAS unsigned*)(F.lds + MISC_OFF); M_[20] = M_[20] + (unsigned)(__builtin_amdgcn_s_memrealtime() - tpr0_); } } while (0)
#if SC_VAR >= 0
#define IDX_SCORE_EXTRA() do { __syncthreads(); const unsigned long long tp0_ = __builtin_amdgcn_s_memrealtime(); idx_score_unit<SC_VAR>(F, iq, kidx, misc, scr, mb, t0, L); __syncthreads(); \
        if (F.wave == 0 && fresh_lane() == 0) { LAS unsigned* M_ = (LAS unsigned*)(F.lds + MISC_OFF); M_[20] = M_[20] + (unsigned)(__builtin_amdgcn_s_memrealtime() - tp0_); } } while (0)
#else
#define IDX_SCORE_EXTRA() do { } while (0)
#endif
template <int VAR> __device__ __forceinline__ void idx_score_unit(const Frame& F, const bf16* iq, const bf16* kidx, const float* misc, f16* scr, const size_t mb, const int t0, const int L) {
    const int lane = fresh_lane(), wave = F.wave, tid = wave * 64 + lane;
    const float wscale = 0.25f * 0.08838834764831845f;
        bf16x8 afr[2][8]; float wq[2][16];
#pragma unroll
        for (int rt = 0; rt < 2; ++rt) {
            const int r = lane & 31, q = (r >> 2) & 1, head = 4 * (r >> 3) + (r & 3);
            const bf16* src = iq + (mb + t0 + 4 * wave + 2 * rt + q) * DM + head * IDIM + 8 * (lane >> 5);
#pragma unroll
            for (int ks = 0; ks < 8; ++ks) afr[rt][ks] = *(const bf16x8*)(src + ks * 16);
            const float* wsrc = misc + (mb + t0 + 4 * wave + 2 * rt + (lane >> 5)) * 256 + 128;
#pragma unroll
            for (int i4 = 0; i4 < 4; ++i4) { const f32x4 w4 = *(const f32x4*)(wsrc + 4 * i4); wq[rt][4 * i4 + 0] = w4.x * wscale; wq[rt][4 * i4 + 1] = w4.y * wscale; wq[rt][4 * i4 + 2] = w4.z * wscale; wq[rt][4 * i4 + 3] = w4.w * wscale; }
        }
        const int nkt = L / 64;
        u32x4 st[2];
#define IDX_LOADK(KT) do { _Pragma("unroll") for (int i = 0; i < 2; ++i) { const int e = tid + 512 * i, key = e >> 4, ch = e & 15; st[i] = *(const u32x4*)(kidx + (mb + (KT) * 64 + key) * IDIM + ch * 8); } } while (0)
#define IDX_STOREK(BI) do { _Pragma("unroll") for (int i = 0; i < 2; ++i) { const int e = tid + 512 * i, key = e >> 4, ch = e & 15; *(LAS u32x4*)(F.lds + (BI) * IDX_KBUF + key * IDX_KROW + ch * 16) = st[i]; } } while (0)
        IDX_LOADK(0); IDX_STOREK(0);
        if (nkt > 1) { IDX_LOADK(1); IDX_STOREK(1); }
        __syncthreads();
        bf16x8 bf0[8], bf1[8];
#pragma unroll
        for (int ks = 0; ks < 8; ++ks) bf0[ks] = *(const LAS bf16x8*)(F.lds + (lane & 31) * IDX_KROW + (ks * 16 + 8 * (lane >> 5)) * 2);
        f32x16 accA, accB;
#pragma unroll
        for (int i = 0; i < 16; ++i) accB[i] = 0.f;
        float sprev[2] = {0.f, 0.f};
        unsigned* srow = (unsigned*)scr + (size_t)(4 * wave + (lane >> 5)) * (SEQ / 2) + (lane & 31);
        int cur = 0;
#define IDX_MMA(ACC, RT, BF) do { _Pragma("unroll") for (int i = 0; i < 16; ++i) ACC[i] = 0.f; \
        if (VAR & 16) { asm volatile("" : "+v"(ACC) : "v"(BF[0]), "v"(BF[7])); } else { _Pragma("unroll") for (int ks = 0; ks < 8; ++ks) ACC = __builtin_amdgcn_mfma_f32_32x32x16_bf16(afr[RT][ks], BF[ks], ACC, 0, 0, 0); } } while (0)
#define IDX_EPI(ACC, RT, SUB, SR, DO) do { if (VAR & 2) { asm volatile("" :: "v"(ACC)); break; } float s_ = 0.f; _Pragma("unroll") for (int i = 0; i < 16; ++i) { const float af_ = ACC[i]; const int ai_ = __builtin_bit_cast(int, af_); s_ += wq[RT][i] * __builtin_bit_cast(float, ai_ > 0 ? ai_ : 0); } \
        if ((SUB) == 0) sprev[RT] = s_; else { const f16 lo_ = (f16)sprev[RT], hi_ = (f16)s_; const unsigned pk_ = (unsigned)__builtin_bit_cast(unsigned short, lo_) | ((unsigned)__builtin_bit_cast(unsigned short, hi_) << 16); \
            if (VAR & 1) asm volatile("" :: "v"(pk_)); else if (DO) (SR)[(size_t)(2 * (RT)) * (SEQ / 2)] = pk_; } } while (0)
#define IDX_ILV() do { _Pragma("unroll") for (int k_ = 0; k_ < 8; ++k_) { __builtin_amdgcn_sched_group_barrier(0x008, 1, 0); __builtin_amdgcn_sched_group_barrier(0x002, 5, 0); } } while (0)
        for (int kt = 0; kt < nkt; ++kt) {
            const int nxt = cur == 2 ? 0 : cur + 1, nx2 = nxt == 2 ? 0 : nxt + 1;
            if (!(VAR & 4)) { const int ktl = kt + 2 < nkt ? kt + 2 : nkt - 1; IDX_LOADK(ktl); __builtin_amdgcn_sched_barrier(0); }
            LAS unsigned char* buf = F.lds + cur * IDX_KBUF;
#pragma unroll
            for (int ks = 0; ks < 8; ++ks) bf1[ks] = *(const LAS bf16x8*)(buf + (32 + (lane & 31)) * IDX_KROW + (ks * 16 + 8 * (lane >> 5)) * 2);
            unsigned* srp = kt > 0 ? srow - 32 : srow;
            IDX_MMA(accA, 0, bf0); IDX_EPI(accB, 1, 1, srp, true); IDX_ILV();
            IDX_MMA(accB, 1, bf0); IDX_EPI(accA, 0, 0, srow, true); IDX_ILV();
            {   LAS unsigned char* nb = F.lds + nxt * IDX_KBUF;
#pragma unroll
                for (int ks = 0; ks < 8; ++ks) bf0[ks] = *(const LAS bf16x8*)(nb + (lane & 31) * IDX_KROW + (ks * 16 + 8 * (lane >> 5)) * 2);
            }
            IDX_MMA(accA, 0, bf1); IDX_EPI(accB, 1, 0, srow, true); IDX_ILV();
            IDX_MMA(accB, 1, bf1); IDX_EPI(accA, 0, 1, srow, true); IDX_ILV();
            __builtin_amdgcn_sched_barrier(0);
            if (!(VAR & 4)) IDX_STOREK(nx2);
            if (!(VAR & 8)) __syncthreads();
            srow += 32; cur = nxt;
        }
        IDX_EPI(accB, 1, 1, srow - 32, true);
#undef IDX_MMA
#undef IDX_EPI
#undef IDX_ILV
#undef IDX_LOADK
#undef IDX_STOREK
}
template <int NSEL> __device__ __forceinline__ void p3_indexer(const Params& p, const Frame& F) {
    const int lane = F.lane, wave = F.wave, tid = F.tid;
    const bf16* iq = (const bf16*)(p.ws + WS_IQ); const bf16* kidx = (const bf16*)(p.ws + WS_KIDX); const float* misc = (const float*)(p.ws + WS_MISC);
    u16* idxo = (u16*)(p.ws + WS_IDX);
    f16* scr = (f16*)(p.ws + WS_SCR) + (size_t)F.bid * 32 * SEQ;
    const float wscale = 0.25f * 0.08838834764831845f;
    for (int uu = F.bid; uu < 512; uu += F.G) {
        const int b = uu & 1; int hc = (uu & 255) >> 1; if (uu >> 8) hc = 255 - hc;
        const int c = hc >> 1, L = (c + 1) * CHUNK, t0 = hc * 32; const size_t mb = (size_t)b * SEQ;
        if (L <= TOPK) {
#pragma unroll
            for (int q = 0; q < 4; ++q) { u16* o = idxo + (mb + t0 + 4 * wave + q) * TOPK;
#pragma unroll
                for (int j = 0; j < 4; ++j) { const int i = lane + 64 * j; o[i] = (u16)(i < L ? i : 0); } }
            continue;
        }
        IDX_SCORE_EXTRA();
        { TPR_BEGIN(1); idx_score_unit<0>(F, iq, kidx, misc, scr, mb, t0, L); TPR_END(1); }
        VM_WAIT();
        __builtin_amdgcn_fence(__ATOMIC_ACQUIRE, "agent");
        VM_WAIT();
        { TPR_BEGIN(2);
#pragma unroll 1
        for (int q = 0; q < 4 * NSEL; ++q)
            idx_select_query((const unsigned*)(scr + (size_t)(4 * wave + (q & 3)) * SEQ), L, idxo + (mb + t0 + 4 * wave + (q & 3)) * TOPK, lane, F.lds + IDX_STG_OFF + wave * IDX_STG_W);
        VM_WAIT();
        TPR_END(2); }
    }
}

constexpr int DSA_ROW = 544, DSA_WBUF = 16 * DSA_ROW, DSA_WREG = 2 * DSA_WBUF;
constexpr int DSA_IDX_OFF = 8 * DSA_WREG, DSA_BKT_OFF = DSA_IDX_OFF + 8 * 512, DSA_BIAS_OFF = DSA_BKT_OFF + 8 * 256;
static_assert(DSA_BIAS_OFF + 2048 <= MISC_OFF, "dsa lds");
__device__ __forceinline__ unsigned t5_bucket(int rel) {
    const unsigned ret = rel > 0 ? 16u : 0u; const int n = rel < 0 ? -rel : rel; unsigned v;
    if (n < 8) v = (unsigned)n; else { const unsigned n2 = (unsigned)n * (unsigned)n; v = 2u + (31u - (unsigned)__clz((int)n2)); if (v > 15u) v = 15u; }
    return ret + v;
}
__device__ __forceinline__ void p4_dsa(const Params& p, const Frame& F) {
    const int lane = F.lane, wave = F.wave, g = lane >> 4, l15 = lane & 15;
    const u16* idx = (const u16*)(p.ws + WS_IDX); const bf16* clat = (const bf16*)(p.ws + WS_CLAT);
    const bf16* qlat = (const bf16*)p.out; bf16* olat = (bf16*)p.out;
    LAS float* biasT = (LAS float*)(F.lds + DSA_BIAS_OFF);
    biasT[F.tid] = KARG_IN(I_RELB)[F.tid];
    __syncthreads();
    LAS unsigned char* wb = F.lds + wave * DSA_WREG;
    LAS u16* widx = (LAS u16*)(F.lds + DSA_IDX_OFF + wave * 512);
    LAS unsigned* wbkt = (LAS unsigned*)(F.lds + DSA_BKT_OFF + wave * 256);
    const float SC = 0.08838834764831845f;
    for (int uu = F.bid; uu < 512; uu += F.G)
    for (int qq = 0; qq < 4; ++qq) {
        const int ub = uu & 1; int uhc = (uu & 255) >> 1; if (uu >> 8) uhc = 255 - uhc;
        const int mq = ub * SEQ + uhc * 32 + 4 * wave + qq;
        const int tpos = mq & (SEQ - 1), b = mq >> 13, c = tpos >> 6;
        const int n = ((c + 1) * CHUNK < TOPK) ? (c + 1) * CHUNK : TOPK, ntile = n >> 4;
        const u32x2 iv = *(const u32x2*)(idx + (size_t)mq * TOPK + 4 * lane);
        *(LAS u32x2*)(widx + 4 * lane) = iv;
        wbkt[lane] = t5_bucket((int)(iv.x & 0xffffu) - tpos) | (t5_bucket((int)(iv.x >> 16) - tpos) << 8) | (t5_bucket((int)(iv.y & 0xffffu) - tpos) << 16) | (t5_bucket((int)(iv.y >> 16) - tpos) << 24);
        bf16x8 bq[8];
        { const bf16* qs = qlat + (size_t)mq * 4096 + l15 * 256 + 8 * g;
#pragma unroll
          for (int kk = 0; kk < 8; ++kk) bq[kk] = *(const bf16x8*)(qs + 32 * kk); }
        LDS_WAIT();
        const bf16* cb = clat + (size_t)b * SEQ * DLAT + (lane & 31) * 8;
        u32x4 grA[8], grB[8];
#define DSA_GATHER(T_, GR_) do { _Pragma("unroll") for (int i = 0; i < 8; ++i) { const unsigned key = widx[16 * (T_) + 2 * i + (lane >> 5)]; GR_[i] = *(const u32x4*)(cb + (size_t)key * DLAT); } } while (0)
#define DSA_PUT(BUF_, GR_) do { _Pragma("unroll") for (int i = 0; i < 8; ++i) *(LAS u32x4*)((BUF_) + (2 * i + (lane >> 5)) * DSA_ROW + (lane & 31) * 16) = GR_[i]; } while (0)
#define DSA_TILE(T_, BUF_) do { LAS unsigned char* buf = (BUF_); \
            f32x4 s = (f32x4){0.f, 0.f, 0.f, 0.f}; \
            _Pragma("unroll") for (int kk = 0; kk < 8; ++kk) { const bf16x8 a = *(const LAS bf16x8*)(buf + l15 * DSA_ROW + (32 * kk + 8 * g) * 2); s = __builtin_amdgcn_mfma_f32_16x16x32_bf16(a, bq[kk], s, 0, 0, 0); } \
            const unsigned bk = wbkt[4 * (T_) + g]; \
            float x[4]; \
            _Pragma("unroll") for (int r = 0; r < 4; ++r) x[r] = s[r] * SC + biasT[((bk >> (8 * r)) & 0xffu) * 16 + l15]; \
            float tm = fmaxf(fmaxf(x[0], x[1]), fmaxf(x[2], x[3])); \
            tm = x16_max(tm); tm = x32_max(tm); \
            if (__any(tm > mrun)) { const float mn = fmaxf(mrun, tm), al = __expf(mrun - mn); \
                _Pragma("unroll") for (int mt = 0; mt < 16; ++mt) O[mt] = O[mt] * al; \
                lsum *= al; mrun = mn; } \
            float pr[4]; \
            _Pragma("unroll") for (int r = 0; r < 4; ++r) { pr[r] = __expf(x[r] - mrun); lsum += pr[r]; } \
            u32x2 pw; pw.x = cvt_pk_bf16(pr[0], pr[1]); pw.y = cvt_pk_bf16(pr[2], pr[3]); \
            const bf16x4 pf = __builtin_bit_cast(bf16x4, pw); \
            const LAS unsigned char* trb = buf + (4 * g + (l15 >> 2)) * DSA_ROW + (4 * (lane & 3)) * 2; \
            _Pragma("unroll") for (int mt = 0; mt < 16; ++mt) { \
                const bf16x4 a4 = __builtin_bit_cast(bf16x4, __builtin_amdgcn_ds_read_tr16_b64_v4i16((LAS v4i16_t*)(trb + mt * 32))); \
                O[mt] = __builtin_amdgcn_mfma_f32_16x16x16bf16_1k(a4, pf, O[mt], 0, 0, 0); } } while (0)
        DSA_GATHER(0, grA);
        DSA_GATHER(1, grB);
        DSA_PUT(wb, grA);
        f32x4 O[16];
#pragma unroll
        for (int mt = 0; mt < 16; ++mt) O[mt] = (f32x4){0.f, 0.f, 0.f, 0.f};
        float mrun = -INFINITY, lsum = 0.f;
        for (int T = 0; T < ntile; T += 2) {
            if (T + 2 < ntile) DSA_GATHER(T + 2, grA);
            asm volatile("" ::: "memory");
            DSA_TILE(T, wb);
            asm volatile("" ::: "memory");
            DSA_PUT(wb + DSA_WBUF, grB);
            if (T + 3 < ntile) DSA_GATHER(T + 3, grB);
            asm volatile("" ::: "memory");
            DSA_TILE(T + 1, wb + DSA_WBUF);
            asm volatile("" ::: "memory");
            if (T + 2 < ntile) DSA_PUT(wb, grA);
        }
#undef DSA_GATHER
#undef DSA_PUT
#undef DSA_TILE
        lsum = x16_sum(lsum); lsum = x32_sum(lsum);
        const float inv = __frcp_rn(lsum);
        bf16* od = olat + (size_t)mq * 4096 + l15 * 256 + 4 * g;
#pragma unroll
        for (int mt = 0; mt < 16; ++mt) { u32x2 w; w.x = cvt_pk_bf16(O[mt][0] * inv, O[mt][1] * inv); w.y = cvt_pk_bf16(O[mt][2] * inv, O[mt][3] * inv); *(u32x2*)(od + 16 * mt) = w; }
        LDS_WAIT();
    }
}

constexpr int G1_ROW = 528, G1_ARR = 64 * G1_ROW, G1_GA = 4 * G1_ARR, G1_TOT = G1_GA + 4096, G1_VROW = 1040;
static_assert(G1_TOT + 2048 <= MISC_OFF && 64 * G1_VROW <= G1_GA, "g1 lds");
__device__ __forceinline__ void p6_gla1(const Params& p, const Frame& F) {
    const int tid = F.tid, lane = F.lane, wave = F.wave, g = lane >> 4, l15 = lane & 15;
    const bf16* gqk = (const bf16*)(p.ws + WS_IQ); const bf16* gv = (const bf16*)(p.ws + WS_DQ); const float* misc = (const float*)(p.ws + WS_MISC);
    bf16* qfp = (bf16*)(p.ws + WS_QFP); bf16* kdt = (bf16*)(p.ws + WS_KDT); bf16* sc = (bf16*)(p.ws + WS_SC); bf16* vt = (bf16*)(p.ws + WS_GVT); float* dec = (float*)(p.ws + WS_DCRAW);
    LAS unsigned char* lds = F.lds;
    LAS float* GA = (LAS float*)(lds + G1_GA); LAS float* TOT = (LAS float*)(lds + G1_TOT);
    for (int uu = F.bid; uu < 1024; uu += F.G) {
        const int b = uu >> 9, h = (uu >> 7) & 3, c = uu & 127; const size_t m0 = (size_t)b * SEQ + c * CHUNK;
        { const int e = tid * 2, t = e >> 4, j = e & 15; *(LAS f32x2*)(GA + t * 16 + j) = *(const f32x2*)(misc + (m0 + t) * 256 + 144 + j); }
        {
#pragma unroll
            for (int i = 0; i < 4; ++i) { const int e = tid + 512 * i, t = e >> 5, ch = e & 31;
                *(LAS u32x4*)(lds + 0 * G1_ARR + t * G1_ROW + ch * 16) = *(const u32x4*)(gqk + (m0 + t) * DM + h * GDK + ch * 8);
                *(LAS u32x4*)(lds + 3 * G1_ARR + t * G1_ROW + ch * 16) = *(const u32x4*)(gqk + (m0 + t) * DM + 1024 + h * GDK + ch * 8); }
        }
        const int half = tid >> 8, d = tid & 255;
        float w2[16];
#pragma unroll
        for (int j = 0; j < 16; ++j) w2[j] = KARG_IN(I_WA2)[j * 1024 + h * 256 + d];
        const float ba = KARG_IN(I_BA)[h * 256 + d];
        __syncthreads();
        float la[32]; float run = 0.f;
#pragma unroll
        for (int i = 0; i < 32; ++i) {
            const LAS f32x4* ga4 = (const LAS f32x4*)(GA + (32 * half + i) * 16);
            float x = ba;
#pragma unroll
            for (int j4 = 0; j4 < 4; ++j4) { const f32x4 a = ga4[j4]; x += a.x * w2[4 * j4] + a.y * w2[4 * j4 + 1] + a.z * w2[4 * j4 + 2] + a.w * w2[4 * j4 + 3]; }
            const float ls = fminf(x, 0.f) - __logf(1.0f + __expf(-fabsf(x)));
            run += ls * 0.0625f; la[i] = run;
        }
        TOT[half * 256 + d] = run;
        __syncthreads();
        const float off = half ? TOT[d] : 0.f, blast = TOT[d] + TOT[256 + d];
        unsigned kdp[16];
#pragma unroll
        for (int i = 0; i < 32; ++i) {
            const int t = 32 * half + i; const float bc = off + la[i];
            const float eb = __expf(bc), ebi = __expf(-bc);
            const float q = bf2f(*(const LAS bf16*)(lds + 0 * G1_ARR + t * G1_ROW + d * 2)) * 0.0625f, k = bf2f(*(const LAS bf16*)(lds + 3 * G1_ARR + t * G1_ROW + d * 2));
            const unsigned qq = cvt_pk_bf16(q * eb, q * ebi), kk = cvt_pk_bf16(k * eb, k * ebi);
            *(LAS bf16*)(lds + 0 * G1_ARR + t * G1_ROW + d * 2) = (bf16)(qq & 0xffffu);
            *(LAS bf16*)(lds + 2 * G1_ARR + t * G1_ROW + d * 2) = (bf16)(qq >> 16);
            *(LAS bf16*)(lds + 3 * G1_ARR + t * G1_ROW + d * 2) = (bf16)(kk & 0xffffu);
            *(LAS bf16*)(lds + 1 * G1_ARR + t * G1_ROW + d * 2) = (bf16)(kk >> 16);
            const float kd = k * __expf(blast - bc);
            if (i & 1) kdp[i >> 1] = cvt_pk_bf16(__uint_as_float(kdp[i >> 1]), kd); else kdp[i >> 1] = __float_as_uint(kd);
        }
        { bf16* kb = kdt + (((size_t)uu * 16 + (d >> 4)) * 2 + half) * 512 + (d & 15) * 8;
#pragma unroll
          for (int j = 0; j < 4; ++j) *(u32x4*)(kb + j * 128) = (u32x4){kdp[4 * j], kdp[4 * j + 1], kdp[4 * j + 2], kdp[4 * j + 3]}; }
        if (half == 0) dec[(size_t)uu * 256 + d] = __expf(blast);
        __syncthreads();
        {
#pragma unroll
            for (int bi = 0; bi < 4; ++bi) { const int blk = wave * 4 + bi, tt = blk >> 3, kk = blk & 7;
                const LAS unsigned char* rp = lds + 0 * G1_ARR + (16 * tt + l15) * G1_ROW + (32 * kk + 4 * g) * 2;
                const u32x2 p1 = *(const LAS u32x2*)rp, p2 = *(const LAS u32x2*)(rp + 32);
                *(u32x4*)(qfp + (((size_t)uu * 4 + tt) * 8 + kk) * 512 + lane * 8) = (u32x4){p1.x, p1.y, p2.x, p2.y}; }
        }
        {
            const int tm = wave >> 1, tn0 = (wave & 1) * 2;
            f32x4 lo[2], up[2];
#pragma unroll
            for (int j = 0; j < 2; ++j) { lo[j] = (f32x4){0.f, 0.f, 0.f, 0.f}; up[j] = (f32x4){0.f, 0.f, 0.f, 0.f}; }
#pragma unroll
            for (int ks = 0; ks < 8; ++ks) {
                const int ao = (16 * tm + l15) * G1_ROW + (32 * ks + 8 * g) * 2;
                const bf16x8 aF = *(const LAS bf16x8*)(lds + 0 * G1_ARR + ao), aB = *(const LAS bf16x8*)(lds + 2 * G1_ARR + ao);
#pragma unroll
                for (int j = 0; j < 2; ++j) {
                    const int bo = (16 * (tn0 + j) + l15) * G1_ROW + (32 * ks + 8 * g) * 2;
                    const bf16x8 bB = *(const LAS bf16x8*)(lds + 1 * G1_ARR + bo), bF = *(const LAS bf16x8*)(lds + 3 * G1_ARR + bo);
                    lo[j] = __builtin_amdgcn_mfma_f32_16x16x32_bf16(aF, bB, lo[j], 0, 0, 0);
                    up[j] = __builtin_amdgcn_mfma_f32_16x16x32_bf16(aB, bF, up[j], 0, 0, 0);
                }
            }
#pragma unroll
            for (int j = 0; j < 2; ++j) { const int s = 16 * (tn0 + j) + l15;
#pragma unroll
                for (int r = 0; r < 4; ++r) { const int t = 16 * tm + 4 * g + r; const float v = (s <= t) ? lo[j][r] : up[j][r];
                    sc[(((size_t)uu * 4 + tm) * 2 + (s >> 5)) * 512 + ((((s >> 3) & 3) * 16 + (t & 15)) * 8) + (s & 7)] = (bf16)(cvt_pk_bf16(v, 0.f) & 0xffffu); } }
        }
        __syncthreads();
#pragma unroll
        for (int i = 0; i < 8; ++i) { const int e = tid + 512 * i, t = e >> 6, ch = e & 63; *(LAS u32x4*)(lds + t * G1_VROW + ch * 16) = *(const u32x4*)(gv + (m0 + t) * DM + h * GDV + ch * 8); }
        __syncthreads();
        { unsigned vp[32];
#pragma unroll
          for (int i = 0; i < 32; ++i) { const unsigned a = *(const LAS bf16*)(lds + (2 * i) * G1_VROW + tid * 2), bb = *(const LAS bf16*)(lds + (2 * i + 1) * G1_VROW + tid * 2); vp[i] = a | (bb << 16); }
          bf16* vb = vt + (((size_t)uu * 32 + (tid >> 4)) * 2) * 512 + (tid & 15) * 8;
#pragma unroll
          for (int j = 0; j < 8; ++j) *(u32x4*)(vb + (j >> 2) * 512 + (j & 3) * 128) = (u32x4){vp[4 * j], vp[4 * j + 1], vp[4 * j + 2], vp[4 * j + 3]}; }
        __syncthreads();
    }
}

constexpr int G2_GRP = 16;
__device__ __forceinline__ void gla_scan_state(const Params& p, const Frame& F) {
    const int lane = F.lane, wave = F.wave, g = lane >> 4, l15 = lane & 15;
    const bf16* kdt = (const bf16*)(p.ws + WS_KDT); const bf16* vt = (const bf16*)(p.ws + WS_GVT); const float* dec = (const float*)(p.ws + WS_DCRAW);
    unsigned* sloc = (unsigned*)(p.ws + WS_S3);
    const int d0 = 4 * (wave & 3), n0 = 4 * (wave >> 2), lo_ = lane * 8;
    for (int uu = F.bid; uu < 256; uu += F.G) {
        const int bh = uu & 7, vq = (uu >> 3) & 3, grp = uu >> 5;
        const size_t ubase = (size_t)bh * 128 + grp * G2_GRP;
        f32x4 sa[4][4];
#pragma unroll
        for (int i = 0; i < 4; ++i)
#pragma unroll
            for (int nt = 0; nt < 4; ++nt) sa[i][nt] = (f32x4){0.f, 0.f, 0.f, 0.f};
        bf16x8 VTa[4][2], KDa[4][2], VTb[4][2], KDb[4][2]; f32x4 DCa[4], DCb[4];
#define G2A_LOAD(cc_, VT_, KD_, DC_) do { const size_t u1_ = ubase + (cc_); const bf16* vtu = vt + ((u1_ * 32 + vq * 8 + n0) * 2) * 512; const bf16* kdu = kdt + ((u1_ * 16 + d0) * 2) * 512; const float* dcu = dec + u1_ * 256 + 16 * d0; \
        _Pragma("unroll") for (int nt = 0; nt < 4; ++nt) { _Pragma("unroll") for (int kk = 0; kk < 2; ++kk) VT_[nt][kk] = *(const bf16x8*)((vtu + (nt * 2 + kk) * 512) + lo_); } \
        _Pragma("unroll") for (int i = 0; i < 4; ++i) { _Pragma("unroll") for (int kk = 0; kk < 2; ++kk) KD_[i][kk] = *(const bf16x8*)((kdu + (i * 2 + kk) * 512) + lo_); \
            DC_[i] = *(const f32x4*)(dcu + (4 * g + 16 * i)); } } while (0)
#define G2A_UPD(VT_, KD_, DC_) do { _Pragma("unroll") for (int i = 0; i < 4; ++i) { _Pragma("unroll") for (int nt = 0; nt < 4; ++nt) { sa[i][nt] = sa[i][nt] * DC_[i]; \
        sa[i][nt] = __builtin_amdgcn_mfma_f32_16x16x32_bf16(KD_[i][0], VT_[nt][0], sa[i][nt], 0, 0, 0); \
        sa[i][nt] = __builtin_amdgcn_mfma_f32_16x16x32_bf16(KD_[i][1], VT_[nt][1], sa[i][nt], 0, 0, 0); } } } while (0)
        G2A_LOAD(0, VTa, KDa, DCa);
#pragma unroll 1
        for (int cc = 0; cc < G2_GRP; cc += 2) {
            G2A_LOAD(cc + 1, VTb, KDb, DCb);
            G2A_UPD(VTa, KDa, DCa);
            if (cc + 2 < G2_GRP) G2A_LOAD(cc + 2, VTa, KDa, DCa);
            G2A_UPD(VTb, KDb, DCb);
        }
#undef G2A_LOAD
#undef G2A_UPD
        u32x2* ub = (u32x2*)sloc + (size_t)uu * 8192;
#pragma unroll
        for (int i = 0; i < 4; ++i)
#pragma unroll
            for (int nt = 0; nt < 4; ++nt) { u32x2* tp = ub + ((d0 + i) * 8 + n0 + nt) * 64; u32x2 w; w.x = cvt_pk_bf16(sa[i][nt][0], sa[i][nt][1]); w.y = cvt_pk_bf16(sa[i][nt][2], sa[i][nt][3]); tp[(unsigned)lane] = w; }
    }
}
constexpr int G2L_SB = 0, G2L_QF = 65536, G2L_KD = 98304, G2L_VT = 131072, G2L_SC = 147456;
static_assert(G2L_SC + 8192 <= MISC_OFF, "scan lds");
__device__ __forceinline__ void gla_scan_full(const Params& p, const Frame& F, bf16* oraw) {
    const int lane = F.lane, wave = F.wave, g = lane >> 4, l15 = lane & 15;
    const bf16* qfp = (const bf16*)(p.ws + WS_QFP); const bf16* kdt = (const bf16*)(p.ws + WS_KDT); const bf16* sc = (const bf16*)(p.ws + WS_SC); const bf16* vt = (const bf16*)(p.ws + WS_GVT); const float* dec = (const float*)(p.ws + WS_DCRAW);
    const unsigned* sloc = (const unsigned*)(p.ws + WS_S3);
    LAS unsigned char* lds = F.lds;
    const int tw = wave & 3, d0 = 4 * (wave & 3), n0 = 4 * (wave >> 2);
#define G2D_COPY(gsrc_, ldsoff_, nblk_) do { _Pragma("unroll") for (int b_ = 0; b_ < (nblk_); ++b_) \
        __builtin_amdgcn_global_load_lds((const unsigned*)((const char*)(gsrc_) + (size_t)(wave * (nblk_) + b_) * 1024 + lane * 16), (LAS unsigned*)(lds + (ldsoff_) + (wave * (nblk_) + b_) * 1024), 16, 0, 0); } while (0)
#define G2D_ISSUE_QF(cc_) do { const size_t u1_ = ubase + (cc_); G2D_COPY(qfp + u1_ * 16384, G2L_QF, 4); } while (0)
#define G2D_ISSUE_VKS(cc_) do { const size_t u1_ = ubase + (cc_); G2D_COPY(vt + (u1_ * 32 + vq * 8) * 1024, G2L_VT, 2); G2D_COPY(kdt + u1_ * 16384, G2L_KD, 4); G2D_COPY(sc + u1_ * 4096, G2L_SC, 1); } while (0)
#define G2D_PUBLISH() do { _Pragma("unroll") for (int nt = 0; nt < 4; ++nt) { _Pragma("unroll") for (int j = 0; j < 2; ++j) { u32x4 w; \
        w.x = cvt_pk_bf16(sa[2 * j][nt][0], sa[2 * j][nt][1]); w.y = cvt_pk_bf16(sa[2 * j][nt][2], sa[2 * j][nt][3]); w.z = cvt_pk_bf16(sa[2 * j + 1][nt][0], sa[2 * j + 1][nt][1]); w.w = cvt_pk_bf16(sa[2 * j + 1][nt][2], sa[2 * j + 1][nt][3]); \
        *(LAS u32x4*)(lds + G2L_SB + ((n0 + nt) * 8 + 2 * tw + j) * 1024 + lane * 16) = w; } } } while (0)
#define G2D_BAR() do { asm volatile("s_waitcnt vmcnt(0) lgkmcnt(0)" ::: "memory"); __syncthreads(); } while (0)
    for (int uu = F.bid; uu < 256; uu += F.G) {
        const int bh = uu & 7, vq = (uu >> 3) & 3, grp = uu >> 5;
        const size_t ubase = (size_t)bh * 128 + grp * G2_GRP;
        G2D_ISSUE_VKS(0); G2D_ISSUE_QF(0);
        f32x4 sa[4][4];
#pragma unroll
        for (int i = 0; i < 4; ++i)
#pragma unroll
            for (int nt = 0; nt < 4; ++nt) sa[i][nt] = (f32x4){0.f, 0.f, 0.f, 0.f};
#pragma unroll 1
        for (int j = 0; j < grp; ++j) {
            f32x4 D[4];
#pragma unroll
            for (int i = 0; i < 4; ++i) {
                f32x4 d = *(const f32x4*)(dec + ((size_t)bh * 128 + j * G2_GRP + l15) * 256 + 16 * (d0 + i) + 4 * g);
#pragma unroll
                for (int e = 0; e < 4; ++e) { float v = d[e]; v *= swz_<1>(v); v *= swz_<2>(v); v *= swz_<4>(v); v *= swz_<8>(v); d[e] = v; }
                D[i] = d; }
            const u32x2* ub = (const u32x2*)sloc + (size_t)(bh + 8 * vq + 32 * j) * 8192;
            unsigned lj = (unsigned)lane; asm volatile("" : "+v"(lj));
#pragma unroll
            for (int i = 0; i < 4; ++i)
#pragma unroll
                for (int nt = 0; nt < 4; ++nt) { const u32x2* tp = ub + ((d0 + i) * 8 + n0 + nt) * 64; const u32x2 w = tp[lj]; sa[i][nt] = sa[i][nt] * D[i] + (f32x4){bf_lo(w.x), bf_hi(w.x), bf_lo(w.y), bf_hi(w.y)}; }
        }
        G2D_PUBLISH();
        G2D_BAR();
#pragma unroll 1
        for (int cc = 0; cc < G2_GRP; ++cc) {
            const int c = grp * G2_GRP + cc;
            f32x4 DC[4];
            { const float* dcu = dec + (ubase + cc) * 256 + 16 * d0;
#pragma unroll
              for (int i = 0; i < 4; ++i) DC[i] = *(const f32x4*)(dcu + (4 * g + 16 * i)); }
            f32x4 o[4];
#pragma unroll
            for (int ntl = 0; ntl < 4; ++ntl) o[ntl] = (f32x4){0.f, 0.f, 0.f, 0.f};
#pragma unroll
            for (int kk = 0; kk < 8; ++kk) {
                const bf16x8 qf = *(const LAS bf16x8*)(lds + G2L_QF + (tw * 8 + kk) * 1024 + lane * 16);
#pragma unroll
                for (int ntl = 0; ntl < 4; ++ntl) { const bf16x8 sb = *(const LAS bf16x8*)(lds + G2L_SB + ((n0 + ntl) * 8 + kk) * 1024 + lane * 16); o[ntl] = __builtin_amdgcn_mfma_f32_16x16x32_bf16(qf, sb, o[ntl], 0, 0, 0); }
            }
            G2D_BAR();
            if (cc + 1 < G2_GRP) G2D_ISSUE_QF(cc + 1);
            bf16x8 VT[4][2];
#pragma unroll
            for (int nt = 0; nt < 4; ++nt)
#pragma unroll
                for (int kk = 0; kk < 2; ++kk) VT[nt][kk] = *(const LAS bf16x8*)(lds + G2L_VT + ((n0 + nt) * 2 + kk) * 1024 + lane * 16);
            { const bf16x8 s0 = *(const LAS bf16x8*)(lds + G2L_SC + (tw * 2 + 0) * 1024 + lane * 16), s1 = *(const LAS bf16x8*)(lds + G2L_SC + (tw * 2 + 1) * 1024 + lane * 16);
#pragma unroll
              for (int ntl = 0; ntl < 4; ++ntl) {
                o[ntl] = __builtin_amdgcn_mfma_f32_16x16x32_bf16(s0, VT[ntl][0], o[ntl], 0, 0, 0);
                o[ntl] = __builtin_amdgcn_mfma_f32_16x16x32_bf16(s1, VT[ntl][1], o[ntl], 0, 0, 0);
                bf16* od = oraw + ((size_t)(bh * 32 + vq * 8 + n0 + ntl) * SEQ + c * CHUNK + 16 * tw + 4 * g) * 16 + l15;
#pragma unroll
                for (int r = 0; r < 4; ++r) od[r * 16] = (bf16)(cvt_pk_bf16(o[ntl][r], 0.f) & 0xffffu);
              } }
#pragma unroll
            for (int i = 0; i < 4; ++i) {
                const bf16x8 k0 = *(const LAS bf16x8*)(lds + G2L_KD + ((d0 + i) * 2 + 0) * 1024 + lane * 16), k1 = *(const LAS bf16x8*)(lds + G2L_KD + ((d0 + i) * 2 + 1) * 1024 + lane * 16);
#pragma unroll
                for (int nt = 0; nt < 4; ++nt) { sa[i][nt] = sa[i][nt] * DC[i];
                    sa[i][nt] = __builtin_amdgcn_mfma_f32_16x16x32_bf16(k0, VT[nt][0], sa[i][nt], 0, 0, 0);
                    sa[i][nt] = __builtin_amdgcn_mfma_f32_16x16x32_bf16(k1, VT[nt][1], sa[i][nt], 0, 0, 0); }
            }
            G2D_PUBLISH();
            G2D_BAR();
            if (cc + 1 < G2_GRP) G2D_ISSUE_VKS(cc + 1);
        }
        G2D_BAR();
    }
#undef G2D_COPY
#undef G2D_ISSUE_QF
#undef G2D_ISSUE_VKS
#undef G2D_PUBLISH
#undef G2D_BAR
}

__device__ __forceinline__ void p8_gla3(const Params& p, const Frame& F) {
    const int gw = F.bid * NWAVES + F.wave, NGW = F.G * NWAVES, lane = F.lane;
    const bf16* oraw = (const bf16*)(p.ws + WS_DQ); const bf16* gr = (const bf16*)(p.ws + WS_GR); bf16* yg = (bf16*)(p.ws + WS_S2);
    const f32x4 g0 = ((const f32x4*)KARG_IN(I_GONORM))[2 * lane], g1 = ((const f32x4*)KARG_IN(I_GONORM))[2 * lane + 1];
    const float gg[8] = {g0.x, g0.y, g0.z, g0.w, g1.x, g1.y, g1.z, g1.w};
    for (int m4 = gw * 4; m4 < M; m4 += NGW * 4) {
        const int b = m4 >> 13, t4 = m4 & (SEQ - 1);
        u32x4 ow[4][4], rw[4][4];
#pragma unroll
        for (int k = 0; k < 4; ++k)
#pragma unroll
            for (int hh = 0; hh < GH; ++hh) {
                ow[k][hh] = *(const u32x4*)(oraw + ((size_t)((b * GH + hh) * 32 + (lane >> 1)) * SEQ + t4 + k) * 16 + (lane & 1) * 8);
                rw[k][hh] = *((const u32x4*)(gr + (size_t)(m4 + k) * DM + hh * GDV) + lane); }
#pragma unroll
        for (int k = 0; k < 4; ++k)
#pragma unroll
            for (int hh = 0; hh < GH; ++hh) {
                const u32x4 a = ow[k][hh], rr = rw[k][hh];
                float o[8] = {bf_lo(a.x), bf_hi(a.x), bf_lo(a.y), bf_hi(a.y), bf_lo(a.z), bf_hi(a.z), bf_lo(a.w), bf_hi(a.w)};
                const float r[8] = {bf_lo(rr.x), bf_hi(rr.x), bf_lo(rr.y), bf_hi(rr.y), bf_lo(rr.z), bf_hi(rr.z), bf_lo(rr.w), bf_hi(rr.w)};
                float ss = 0.f;
#pragma unroll
                for (int e = 0; e < 8; ++e) ss += o[e] * o[e];
                const float rstd = rsqrtf(wave_sum(ss) * (1.f / GDV) + EPS);
#pragma unroll
                for (int e = 0; e < 8; ++e) o[e] = o[e] * rstd * gg[e] * (r[e] * sigmoidf_(r[e]));
                u32x4 w; w.x = cvt_pk_bf16(o[0], o[1]); w.y = cvt_pk_bf16(o[2], o[3]); w.z = cvt_pk_bf16(o[4], o[5]); w.w = cvt_pk_bf16(o[6], o[7]);
                *((u32x4*)(yg + (size_t)(m4 + k) * DM + hh * GDV) + lane) = w;
            }
    }
}

__device__ __forceinline__ void xa_vt_relayout(const Params& p, const Frame& F) {
    const bf16* kv = (const bf16*)(p.ws + WS_KV); bf16* vT = (bf16*)(p.ws + WS_VT);
    for (int i = F.bid * NTHR + F.tid; i < NB * XH * XDH * NMEM; i += F.G * NTHR) {
        const int pos = i & 255, d = (i >> 8) & 511, h = (i >> 17) & 3, b = i >> 19;
        const int mem = (pos & ~31) + 16 * ((pos >> 2) & 1) + 4 * ((pos >> 3) & 3) + (pos & 3);
        vT[i] = kv[(size_t)(b * NMEM + mem) * 4096 + 2048 + h * XDH + d];
    }
}
constexpr int XA_KROW = 1056, XA_KBUF = 32 * XA_KROW, XA_VROW = 544, XA_VBUF = 32 * XA_VROW, XA_VOFF = 2 * XA_KBUF;
static_assert(XA_VOFF + 2 * XA_VBUF <= MISC_OFF, "xa lds");
__device__ __forceinline__ void p13_xattn(const Params& p, const Frame& F) {
    const int lane = F.lane, wave = F.wave, tid = F.tid, g = lane >> 4, l15 = lane & 15;
    const bf16* qx = (const bf16*)(p.ws + WS_YDSA); const bf16* kv = (const bf16*)(p.ws + WS_KV); const bf16* vT = (const bf16*)(p.ws + WS_VT);
    bf16* o = (bf16*)(p.ws + WS_IQ);
    LAS unsigned char* lds = F.lds;
    const float SCL = 0.044194173824159216f;
    for (int uu = F.bid; uu < 512; uu += F.G) {
        const int b = uu >> 8, h = (uu >> 6) & 3, tb = uu & 63; const size_t m0 = (size_t)b * SEQ + tb * 128 + wave * 16;
        bf16x8 bq[16];
        { const bf16* qs = qx + (m0 + l15) * DM + h * XDH + 8 * g;
#pragma unroll
          for (int kk = 0; kk < 16; ++kk) bq[kk] = *(const bf16x8*)(qs + 32 * kk); }
        const bf16* kbase = kv + (size_t)(b * NMEM) * 4096 + h * XDH;
        const bf16* vbase = vT + (size_t)(b * XH + h) * XDH * NMEM;
        u32x4 st[4];
#pragma unroll
        for (int i = 0; i < 4; ++i) { const int e = tid + 512 * i, row = e >> 6, ch = e & 63; st[i] = *(const u32x4*)(kbase + (size_t)row * 4096 + ch * 8); }
#pragma unroll
        for (int i = 0; i < 4; ++i) { const int e = tid + 512 * i, row = e >> 6, ch = e & 63; *(LAS u32x4*)(lds + row * XA_KROW + ch * 16) = st[i]; }
        __syncthreads();
        f32x4 sT[16];
#pragma unroll
        for (int kt = 0; kt < 8; ++kt) {
            LAS unsigned char* kb = lds + (kt & 1) * XA_KBUF;
            if (kt + 1 < 8) {
#pragma unroll
                for (int i = 0; i < 4; ++i) { const int e = tid + 512 * i, row = e >> 6, ch = e & 63; st[i] = *(const u32x4*)(kbase + (size_t)(32 * (kt + 1) + row) * 4096 + ch * 8); }
            }
#pragma unroll
            for (int sub = 0; sub < 2; ++sub) {
                f32x4 a4 = (f32x4){0.f, 0.f, 0.f, 0.f};
#pragma unroll
                for (int kk = 0; kk < 16; ++kk) { const bf16x8 a = *(const LAS bf16x8*)(kb + (16 * sub + l15) * XA_KROW + kk * 64 + g * 16); a4 = __builtin_amdgcn_mfma_f32_16x16x32_bf16(a, bq[kk], a4, 0, 0, 0); }
                sT[2 * kt + sub] = a4;
            }
            if (kt + 1 < 8) {
                LAS unsigned char* nb = lds + ((kt + 1) & 1) * XA_KBUF;
#pragma unroll
                for (int i = 0; i < 4; ++i) { const int e = tid + 512 * i, row = e >> 6, ch = e & 63; *(LAS u32x4*)(nb + row * XA_KROW + ch * 16) = st[i]; }
            }
            __syncthreads();
        }
#pragma unroll
        for (int i = 0; i < 2; ++i) { const int e = tid + 512 * i, row = e >> 5, ch = e & 31; st[i] = *(const u32x4*)(vbase + (size_t)row * NMEM + ch * 8); }
        float mx = -INFINITY;
#pragma unroll
        for (int mt = 0; mt < 16; ++mt) mx = fmaxf(mx, fmaxf(fmaxf(sT[mt][0], sT[mt][1]), fmaxf(sT[mt][2], sT[mt][3])));
        mx = x16_max(mx); mx = x32_max(mx);
        float sum = 0.f;
#pragma unroll
        for (int mt = 0; mt < 16; ++mt) {
#pragma unroll
            for (int r = 0; r < 4; ++r) { const float e = __expf((sT[mt][r] - mx) * SCL); sT[mt][r] = e; sum += e; } }
        sum = x16_sum(sum); sum = x32_sum(sum);
        const float inv = __frcp_rn(sum);
        bf16x8 pf[8];
#pragma unroll
        for (int kk = 0; kk < 8; ++kk) { u32x4 w; w.x = cvt_pk_bf16(sT[2 * kk][0], sT[2 * kk][1]); w.y = cvt_pk_bf16(sT[2 * kk][2], sT[2 * kk][3]); w.z = cvt_pk_bf16(sT[2 * kk + 1][0], sT[2 * kk + 1][1]); w.w = cvt_pk_bf16(sT[2 * kk + 1][2], sT[2 * kk + 1][3]);
            pf[kk] = __builtin_bit_cast(bf16x8, w); }
#pragma unroll
        for (int i = 0; i < 2; ++i) { const int e = tid + 512 * i, row = e >> 5, ch = e & 31; *(LAS u32x4*)(lds + XA_VOFF + row * XA_VROW + ch * 16) = st[i]; }
        __syncthreads();
        bf16* od = o + (m0 + l15) * DM + h * XDH + 4 * g;
        for (int vt = 0; vt < 16; ++vt) {
            LAS unsigned char* vb = lds + XA_VOFF + (vt & 1) * XA_VBUF;
            if (vt + 1 < 16) {
#pragma unroll
                for (int i = 0; i < 2; ++i) { const int e = tid + 512 * i, row = e >> 5, ch = e & 31; st[i] = *(const u32x4*)(vbase + (size_t)(32 * (vt + 1) + row) * NMEM + ch * 8); }
            }
#pragma unroll
            for (int sub = 0; sub < 2; ++sub) {
                f32x4 a4 = (f32x4){0.f, 0.f, 0.f, 0.f};
#pragma unroll
                for (int kk = 0; kk < 8; ++kk) { const bf16x8 a = *(const LAS bf16x8*)(vb + (16 * sub + l15) * XA_VROW + kk * 64 + g * 16); a4 = __builtin_amdgcn_mfma_f32_16x16x32_bf16(a, pf[kk], a4, 0, 0, 0); }
                u32x2 w; w.x = cvt_pk_bf16(a4[0] * inv, a4[1] * inv); w.y = cvt_pk_bf16(a4[2] * inv, a4[3] * inv);
                *(u32x2*)(od + 16 * (2 * vt + sub)) = w;
            }
            if (vt + 1 < 16) {
                LAS unsigned char* nb = lds + XA_VOFF + ((vt + 1) & 1) * XA_VBUF;
#pragma unroll
                for (int i = 0; i < 2; ++i) { const int e = tid + 512 * i, row = e >> 5, ch = e & 31; *(LAS u32x4*)(nb + row * XA_VROW + ch * 16) = st[i]; }
            }
            __syncthreads();
        }
    }
}

__device__ __forceinline__ float pval_(unsigned u, int mode) {
    float v = mode == 1 ? (float)(u >> 16) * (1.f / 8192.f) : mode == 2 ? __uint_as_float(u) : bf_hi(u);
    if (!(v == v)) v = 3.f;
    return fminf(fmaxf(v, -4.f), 4.f);
}
struct PReg { int a, b, mode; };
template <int K> __device__ __forceinline__ void probe_run(const Params& p, int bid, int G, int wave) {
    constexpr PReg R[19][4] = {
        {{1, 7, 0}, {64, 122, 0}, {128, 192, 0}, {0, 0, 0}},
        {{192, 320, 0}, {27, 59, 2}, {0, 0, 0}, {0, 0, 0}},
        {{7, 19, 0}, {-1, 0, 0}, {0, 0, 0}, {0, 0, 0}},
        {{19, 27, 1}, {0, 0, 0}, {0, 0, 0}, {0, 0, 0}},
        {{-1, 0, 0}, {0, 0, 0}, {0, 0, 0}, {0, 0, 0}},
        {{448, 512, 0}, {0, 0, 0}, {0, 0, 0}, {0, 0, 0}},
        {{192, 384, 0}, {-1, 0, 0}, {0, 0, 0}, {0, 0, 0}},
        {{128, 192, 0}, {384, 448, 0}, {64, 96, 0}, {27, 28, 2}},
        {{256, 320, 0}, {0, 0, 0}, {0, 0, 0}, {0, 0, 0}},
        {{128, 192, 0}, {384, 416, 0}, {0, 0, 0}, {0, 0, 0}},
        {{-1, 0, 0}, {192, 256, 0}, {104, 108, 0}, {0, 0, 0}},
        {{448, 512, 0}, {108, 110, 0}, {0, 0, 0}, {0, 0, 0}},
        {{-1, 0, 2}, {128, 192, 0}, {256, 322, 0}, {0, 0, 0}},
        {{448, 512, 0}, {0, 0, 0}, {0, 0, 0}, {0, 0, 0}},
        {{192, 256, 0}, {0, 0, 0}, {0, 0, 0}, {0, 0, 0}},
        {{448, 512, 0}, {0, 0, 0}, {0, 0, 0}, {0, 0, 0}},
        {{-1, 0, 2}, {128, 192, 0}, {0, 0, 0}, {0, 0, 0}},
        {{328, 504, 0}, {0, 0, 0}, {0, 0, 0}, {0, 0, 0}},
        {{192, 256, 0}, {0, 0, 0}, {0, 0, 0}, {0, 0, 0}},
    };
    const int gt = bid * NTHR + wave * 64 + fresh_lane(), NT = G * NTHR;
    float* tmp = (float*)(p.ws + 512 * 1024);
    float ds = 0.f; bool has_d = false;
#pragma unroll
    for (int r = 0; r < 4; ++r) if (R[K][r].a < 0) { has_d = true; const unsigned* o32 = (const unsigned*)p.out; for (int j = gt; j < M * DM; j += NT) ds += pval_(o32[j], R[K][r].mode); }
    if (has_d) tmp[gt & 131071] = ds * (1.f / 64.f);
}
template <int K> __device__ __forceinline__ void probe_out(const Params& p, int bid, int G, int wave) {
    constexpr PReg R[19][4] = {
        {{1, 7, 0}, {64, 122, 0}, {128, 192, 0}, {0, 0, 0}}, {{192, 320, 0}, {27, 59, 2}, {0, 0, 0}, {0, 0, 0}}, {{7, 19, 0}, {-1, 0, 0}, {0, 0, 0}, {0, 0, 0}}, {{19, 27, 1}, {0, 0, 0}, {0, 0, 0}, {0, 0, 0}},
        {{-1, 0, 0}, {0, 0, 0}, {0, 0, 0}, {0, 0, 0}}, {{448, 512, 0}, {0, 0, 0}, {0, 0, 0}, {0, 0, 0}}, {{192, 384, 0}, {-1, 0, 0}, {0, 0, 0}, {0, 0, 0}}, {{128, 192, 0}, {384, 448, 0}, {64, 96, 0}, {27, 28, 2}},
        {{256, 320, 0}, {0, 0, 0}, {0, 0, 0}, {0, 0, 0}}, {{128, 192, 0}, {384, 416, 0}, {0, 0, 0}, {0, 0, 0}}, {{-1, 0, 0}, {192, 256, 0}, {104, 108, 0}, {0, 0, 0}}, {{448, 512, 0}, {108, 110, 0}, {0, 0, 0}, {0, 0, 0}},
        {{-1, 0, 2}, {128, 192, 0}, {256, 322, 0}, {0, 0, 0}}, {{448, 512, 0}, {0, 0, 0}, {0, 0, 0}, {0, 0, 0}}, {{192, 256, 0}, {0, 0, 0}, {0, 0, 0}, {0, 0, 0}}, {{448, 512, 0}, {0, 0, 0}, {0, 0, 0}, {0, 0, 0}},
        {{-1, 0, 2}, {128, 192, 0}, {0, 0, 0}, {0, 0, 0}}, {{328, 504, 0}, {0, 0, 0}, {0, 0, 0}, {0, 0, 0}}, {{192, 256, 0}, {0, 0, 0}, {0, 0, 0}, {0, 0, 0}},
    };
    const int gt = bid * NTHR + wave * 64 + fresh_lane(), NT = G * NTHR;
    const float* tmp = (const float*)(p.ws + 512 * 1024);
    for (int i = gt; i < M * DM; i += NT) {
        float acc = 0.f;
#pragma unroll
        for (int r = 0; r < 4; ++r) {
            if (R[K][r].a < 0) acc += tmp[i & 131071];
            else if (R[K][r].b > R[K][r].a) { const unsigned* w32 = (const unsigned*)(p.ws + (size_t)R[K][r].a * MiB); const int nw = (R[K][r].b - R[K][r].a) * (int)(MiB / 4);
                for (int j = i; j < nw; j += M * DM) acc += pval_(w32[j], R[K][r].mode); }
        }
        p.out[i] = acc;
    }
}
#define PROBE_EXIT(k) do { if (STOP_AFTER == (k)) { probe_run<(k)>(p, F.bid, F.G, F.wave); GRID_BAR(); probe_out<(k)>(p, F.bid, F.G, F.wave); return; } } while (0)


__device__ __forceinline__ void l2_scrub(const float* x, int bid, int tid) {
    const f32x4* s = (const f32x4*)x + (size_t)(bid & 255) * 32768 + tid; f32x4 a = (f32x4){0.f, 0.f, 0.f, 0.f};
#pragma unroll 8
    for (int i = 0; i < 64; ++i) { const f32x4 v = __builtin_nontemporal_load(s + i * 512); a += v; }
    asm volatile("" :: "v"(a.x + a.y + a.z + a.w));
}

#define NONDET_TEST 0
#ifndef DBL_MASK
#define DBL_MASK 0
#ifndef TP_OFF_US
#define TP_OFF_US 0.0f
#define TP_DIV_US 5.0f
#endif
#endif
#define L2_SCRUB 0
#define G2_TWICE 0
#define NAN_SCRUB 0
#define P11_NOCONV 0
#ifndef PH_MASK
#define PH_MASK 0xffffffffu
#endif
#ifndef STOP_AFTER
#define STOP_AFTER 99
#endif
__global__ void __launch_bounds__(NTHR, 2) fwd_kernel(Params p) {
    extern __shared__ __attribute__((aligned(16))) unsigned char lds_raw[];
    Frame F;
    F.lds = (LAS unsigned char*)lds_raw;
    F.tid = threadIdx.x; F.lane = F.tid & 63; F.wave = __builtin_amdgcn_readfirstlane(F.tid >> 6);
    F.G = gridDim.x; F.bid = blockIdx.x;
    volatile LAS unsigned* MISC = (volatile LAS unsigned*)(F.lds + MISC_OFF);
    if (F.tid < 64) MISC[F.tid] = 0u;
    __syncthreads();
    unsigned char* ws = p.ws;
    XcdBarrier bar = xcd_barrier_post((unsigned*)(ws + WS_CTL) + CW_BAR, MISC + 8, F.wave);
#ifndef TP_BLK
#define TP_BLK -1
#endif
#ifndef TP_BARLO
#define TP_BARLO -1
#define TP_BARHI -1
#endif
#if TP_BARLO >= 0
#define GRID_BAR() do { const unsigned long long tb0_ = __builtin_amdgcn_s_memrealtime(); xcd_barrier(bar); const unsigned long long tb1_ = __builtin_amdgcn_s_memrealtime(); \
        if (F.wave == 0 && fresh_lane() == 0) { const unsigned bi_ = MISC[21]; MISC[21] = bi_ + 1u; if (bi_ >= TP_BARLO && bi_ < TP_BARHI) MISC[20] = MISC[20] + (unsigned)(tb1_ - tb0_); } } while (0)
#else
#define GRID_BAR() xcd_barrier(bar)
#endif
#define FRESH() const int l_ = fresh_lane(); F.lane = l_; F.tid = F.wave * 64 + l_; \
    LAS float* cscr = (LAS float*)(F.lds + F.wave * 16384); const int gw = F.bid * NWAVES + F.wave, NGW = F.G * NWAVES; (void)cscr; (void)gw; (void)NGW
    bf16* S1 = (bf16*)(ws + WS_S1); (void)S1;
    bf16* U = (bf16*)(ws + WS_S2);
    bf16* B3 = (bf16*)(ws + WS_S3);
    bf16* B4 = (bf16*)(ws + WS_S4);
    bf16* B5 = (bf16*)(ws + WS_S5);
    bf16* B7 = (bf16*)(ws + WS_S7);
    bf16* OUTB = (bf16*)p.out;
    pg8::StaticOrder SO;

    { FRESH(); if (PH_MASK & (1u << 0)) p0_prologue(p, F); if (DBL_MASK & 32) p0_prologue(p, F); }
    GRID_BAR();
    PROBE_EXIT(0);
    { pg8::Gemm g{U, (const bf16*)(ws + WS_W1A), M, 4608, DM, DM, 0, 0}; SO.init(M, 4608, F.G, F.bid);
      pg8::EpiP1a E{B3, B4, (float*)(ws + WS_DCRAW), (float*)(ws + WS_MISC)};
      pg8::gemm_phase<pg8::EpiP1a, pg8::StaticOrder>(F.lds, g, SO, E, F.wave); }
    { pg8::Gemm g{(const bf16*)(ws + WS_MEMN), (const bf16*)(ws + WS_WXKV0), NB * NMEM, 2 * DM, DM, DM, 0, 0}; SO.init(NB * NMEM, 2 * DM, F.G, (F.G == 256 && F.bid >= 128) ? F.bid - 128 : (F.G == 256 ? (1 << 20) : F.bid));
      pg8::EpiPlain E{(bf16*)(ws + WS_KV), 2 * DM};
      pg8::gemm_phase<pg8::EpiPlain, pg8::StaticOrder>(F.lds, g, SO, E, F.wave); }
    { FRESH(); __syncthreads();
      if (F.G != 256) p0_late(p, F, gw, NGW); else if (F.bid >= 160) p0_late(p, F, (F.bid - 160) * NWAVES + F.wave, 96 * NWAVES); }
    GRID_BAR();
    PROBE_EXIT(1);
    { FRESH(); if (PH_MASK & (1u << 1)) p2_norms(p, F); }
    { pg8::Gemm g{B4, (const bf16*)(ws + WS_BTUK), M, 4096, 256, DM, 256, 1}; SO.init(M, 4096, F.G, F.bid);
      pg8::EpiPlain E{OUTB, 4096};
      pg8::gemm_phase<pg8::EpiPlain, pg8::StaticOrder>(F.lds, g, SO, E, F.wave); }
    GRID_BAR();
    PROBE_EXIT(2);
    { FRESH(); TPR_BEGIN(4); if (PH_MASK & (1u << 2)) p3_indexer<(DBL_MASK & 1) ? 2 : 1>(p, F); TPR_END(4);
      VM_WAIT(); __builtin_amdgcn_fence(__ATOMIC_ACQUIRE, "agent"); VM_WAIT(); __syncthreads();
      { TPR_BEGIN(3); if (PH_MASK & (1u << 3)) p4_dsa(p, F); TPR_END(3); } }
    GRID_BAR();
    PROBE_EXIT(4);
    { pg8::Gemm g{OUTB, (const bf16*)(ws + WS_BTUV), M, DM, 512, 4096, 512, 0}; SO.init(M, DM, F.G, F.bid);
      pg8::EpiPlain E{B7, DM};
      pg8::gemm_phase<pg8::EpiPlain, pg8::StaticOrder>(F.lds, g, SO, E, F.wave); }
    GRID_BAR();
    PROBE_EXIT(5);
    { pg8::Gemm g{U, (const bf16*)(ws + WS_W1B), M, 10240, DM, DM, 0, 0}; SO.init(M, 10240, F.G, F.bid);
      pg8::EpiP1b E{B3, B4, B5, OUTB, OUTB + (size_t)M * DM};
      pg8::gemm_phase<pg8::EpiP1b, pg8::StaticOrder>(F.lds, g, SO, E, F.wave); }
    GRID_BAR();
    PROBE_EXIT(6);
    { FRESH(); int rot = 1024; if (PH_MASK & (1u << 4)) p6_gla1(p, F); if (DBL_MASK & 2) p6_gla1(p, F);
    conv_seg(KARG_IN(I_WGB), DM, DM, 0, DM, (bf16*)(ws + WS_WGB), DM, 0, 0, cscr, gw, NGW, F.lane, rot);
    conv_seg(KARG_IN(I_WDB), DM, DM, 0, DM, (bf16*)(ws + WS_WDB), DM, 0, 0, cscr, gw, NGW, F.lane, rot);
    conv_seg(KARG_IN(I_WMIX), DM, DM, 0, DM, (bf16*)(ws + WS_WMIX), DM, 0, 0, cscr, gw, NGW, F.lane, rot); }
    GRID_BAR();
    PROBE_EXIT(7);
    { FRESH(); gla_scan_state(p, F); if (DBL_MASK & 4) gla_scan_state(p, F); }
    GRID_BAR();
    { FRESH(); gla_scan_full(p, F, (bf16*)(ws + WS_DQ)); if (DBL_MASK & 256) gla_scan_full(p, F, (bf16*)(ws + WS_DQ)); }
    GRID_BAR();
    PROBE_EXIT(8);
    { FRESH(); int rot = 0; if (L2_SCRUB) l2_scrub(KARG_IN(I_X), F.bid, F.tid); if (PH_MASK & (1u << 6)) p8_gla3(p, F); if (DBL_MASK & 8) p8_gla3(p, F);
    conv_seg(KARG_IN(I_WXQ), DM, DM, 0, DM, (bf16*)(ws + WS_WXQ), DM, 0, 0, cscr, gw, NGW, F.lane, rot);
    conv_seg(KARG_IN(I_WXO), DM, DM, 0, DM, (bf16*)(ws + WS_WXO), DM, 0, 0, cscr, gw, NGW, F.lane, rot); }
    GRID_BAR();
    PROBE_EXIT(9);
    { pg8::Gemm g{B7, (const bf16*)(ws + WS_WDB), M, DM, DM, DM, 0, 0}; SO.init(M, DM, F.G, F.bid);
      pg8::EpiGateMul E{OUTB + (size_t)M * DM};
      pg8::gemm_phase<pg8::EpiGateMul, pg8::StaticOrder>(F.lds, g, SO, E, F.wave); }
    { pg8::Gemm g{U, (const bf16*)(ws + WS_WGB), M, DM, DM, DM, 0, 0}; SO.init(M, DM, F.G, F.bid);
      pg8::EpiMerge E{OUTB, OUTB + (size_t)M * DM, B3};
      pg8::gemm_phase<pg8::EpiMerge, pg8::StaticOrder>(F.lds, g, SO, E, F.wave); }
    GRID_BAR();
    PROBE_EXIT(10);
    { pg8::Gemm g{B3, (const bf16*)(ws + WS_WMIX), M, DM, DM, DM, 0, 0}; SO.init(M, DM, F.G, F.bid);
      pg8::EpiPlain E{B7, DM};
      pg8::gemm_phase<pg8::EpiPlain, pg8::StaticOrder>(F.lds, g, SO, E, F.wave); }
    { FRESH(); xa_vt_relayout(p, F); }
    GRID_BAR();
    PROBE_EXIT(11);
    { FRESH(); for (int m = gw; m < M; m += NGW) resid_row<false, true>(KARG_IN(I_X) + (size_t)m * DM, B7 + (size_t)m * DM, KARG_IN(I_MIXPOST), (bf16*)p.out + (size_t)m * DM, KARG_IN(I_XAPRE), U + (size_t)m * DM, F.lane);
    if (!P11_NOCONV) for (int it = gw; it < 88 * 64; it += NGW) { const int jj = it >> 6, sub = it & 63;
        conv_item((jj & 1) ? KARG_IN(I_WFU) : KARG_IN(I_WFG), DFF, (jj >> 1) * 128, 128, (bf16*)(ws + WS_WFGU), DM, 0, (jj >> 1) * 256 + (jj & 1) * 128, cscr, sub, F.lane); }
    { int rot = (88 * 64) % NGW; if (!P11_NOCONV) conv_seg(KARG_IN(I_WFD), DM, DFF, 0, DM, (bf16*)(ws + WS_WFD), DFF, 0, 0, cscr, gw, NGW, F.lane, rot); } }
    GRID_BAR();
    PROBE_EXIT(12);
    { pg8::Gemm g{U, (const bf16*)(ws + WS_WXQ), M, DM, DM, DM, 0, 0}; SO.init(M, DM, F.G, F.bid);
      pg8::EpiPlain E{B7, DM};
      pg8::gemm_phase<pg8::EpiPlain, pg8::StaticOrder>(F.lds, g, SO, E, F.wave); }
    GRID_BAR();
    PROBE_EXIT(13);
    { FRESH(); if (PH_MASK & (1u << 7)) p13_xattn(p, F); if (DBL_MASK & 16) p13_xattn(p, F); }
    GRID_BAR();
    PROBE_EXIT(14);
    { pg8::Gemm g{B3, (const bf16*)(ws + WS_WXO), M, DM, DM, DM, 0, 0}; SO.init(M, DM, F.G, F.bid);
      pg8::EpiPlain E{B7, DM};
      pg8::gemm_phase<pg8::EpiPlain, pg8::StaticOrder>(F.lds, g, SO, E, F.wave); }
    GRID_BAR();
    PROBE_EXIT(15);
    { FRESH(); for (int m = gw; m < M; m += NGW) resid_row<true, true>((const bf16*)p.out + (size_t)m * DM, B7 + (size_t)m * DM, KARG_IN(I_XAPOST), (bf16*)(ws + WS_S1) + (size_t)m * DM, KARG_IN(I_FFPRE), U + (size_t)m * DM, F.lane); }
    GRID_BAR();
    PROBE_EXIT(16);
    { pg8::Gemm g{U, (const bf16*)(ws + WS_WFGU), M, 2 * DFF, DM, DM, 0, 0}; SO.init(M, 2 * DFF, F.G, F.bid);
      pg8::EpiSwiglu E{(bf16*)(ws + WS_HID)};
      pg8::gemm_phase<pg8::EpiSwiglu, pg8::StaticOrder>(F.lds, g, SO, E, F.wave);
      if (DBL_MASK & 64) pg8::gemm_phase<pg8::EpiSwiglu, pg8::StaticOrder>(F.lds, g, SO, E, F.wave); }
    GRID_BAR();
    PROBE_EXIT(17);
    { pg8::Gemm g{(const bf16*)(ws + WS_HID), (const bf16*)(ws + WS_WFD), M, DM, DFF, DFF, 0, 0}; SO.init(M, DM, F.G, F.bid);
      pg8::EpiPlain E{B3, DM};
      pg8::gemm_phase<pg8::EpiPlain, pg8::StaticOrder>(F.lds, g, SO, E, F.wave); }
    GRID_BAR();
    PROBE_EXIT(18);
    { FRESH(); for (int m = gw; m < M; m += NGW) resid_row<true, false>((const bf16*)(ws + WS_S1) + (size_t)m * DM, B3 + (size_t)m * DM, KARG_IN(I_FFPOST), p.out + (size_t)m * DM, nullptr, nullptr, F.lane); }
#if SC_VAR >= 0 || TP_REGION > 0 || TP_BARLO >= 0
    { __syncthreads();
      if (F.wave == 0 && fresh_lane() == 0 && (TP_BLK < 0 || F.bid == TP_BLK)) __hip_atomic_fetch_add((unsigned*)(ws + WS_CTL) + 64, MISC[20] * (TP_BLK < 0 ? 1u : 256u), __ATOMIC_RELAXED, __HIP_MEMORY_SCOPE_AGENT);
      xcd_barrier(bar);
      if (F.bid == 0 && F.wave == 0 && fresh_lane() == 0) { const unsigned tot = __hip_atomic_load((unsigned*)(ws + WS_CTL) + 64, __ATOMIC_RELAXED, __HIP_MEMORY_SCOPE_AGENT);
          p.out[0] = p.out[0] + ((float)tot * (1.0f / 256.0f) * 0.01f - TP_OFF_US) * (1.0f / TP_DIV_US) + 1.0f; }
    }
#endif
#if NAN_SCRUB
    GRID_BAR();
    { const int gt = F.bid * NTHR + F.wave * 64 + fresh_lane(), NT = F.G * NTHR; for (int i = gt; i < M * DM; i += NT) { const float v = p.out[i]; if (!(fabsf(v) < 1e30f)) p.out[i] = 0.f; } }
#endif
}

extern "C" void kernel_launch(void* const* d_in, const int* in_sizes, int n_in, void* d_out, int out_size, void* d_ws, size_t ws_size, hipStream_t stream) {
    static int grid = 0;
    if (grid == 0) {
        if (n_in != 28 || out_size != M * DM || ws_size < WS_END) { fprintf(stderr, "kernel_launch: unexpected shapes (n_in %d out %d ws %zu)\n", n_in, out_size, ws_size); grid = -1; return; }
        int dev = 0, cus = 0;
        if (hipGetDevice(&dev) != hipSuccess || hipDeviceGetAttribute(&cus, hipDeviceAttributeMultiprocessorCount, dev) != hipSuccess) { grid = -1; return; }
        if (hipFuncSetAttribute((const void*)fwd_kernel, hipFuncAttributeMaxDynamicSharedMemorySize, LDS_BYTES) != hipSuccess) { fprintf(stderr, "kernel_launch: hipFuncSetAttribute failed\n"); grid = -1; return; }
        int per_cu = 0;
        if (hipOccupancyMaxActiveBlocksPerMultiprocessor(&per_cu, (const void*)fwd_kernel, NTHR, LDS_BYTES) != hipSuccess || per_cu < 1) fprintf(stderr, "kernel_launch: occupancy query says %d\n", per_cu);
        (void)hipGetLastError();
        grid = cus;
    }
    if (grid < 0) return;
    (void)in_sizes;
    hipMemsetAsync((char*)d_ws + WS_CTL, 0, CTL_ZERO_BYTES, stream);
    Params p{};
    for (int i = 0; i < 28; ++i) p.in[i] = (const float*)d_in[i];
    p.out = (float*)d_out; p.ws = (unsigned char*)d_ws;
    hipLaunchKernelGGL(fwd_kernel, dim3(grid), dim3(NTHR), LDS_BYTES, stream, p);
}
```

```cpp
#include <hip/hip_runtime.h>
#include <cstdio>
#include <cstdint>

#define GAS __attribute__((address_space(1)))
#define LAS __attribute__((address_space(3)))
typedef unsigned short bf16;
typedef unsigned short u16;
typedef short bf16x8 __attribute__((ext_vector_type(8)));
typedef short bf16x4 __attribute__((ext_vector_type(4)));
typedef float f32x4 __attribute__((ext_vector_type(4)));
typedef float f32x16 __attribute__((ext_vector_type(16)));
typedef float f32x2 __attribute__((ext_vector_type(2)));
typedef unsigned u32x4 __attribute__((ext_vector_type(4)));
typedef unsigned u32x2 __attribute__((ext_vector_type(2)));
typedef short v4i16_t __attribute__((ext_vector_type(4)));
typedef _Float16 f16;

#define G2_XSYNC 0
constexpr int DM = 2048, NB = 2, SEQ = 8192, M = NB * SEQ, CHUNK = 64, NCH = SEQ / CHUNK;
constexpr int NMEM = 256, GH = 4, GDK = 256, GDV = 512, GRANK = 16;
constexpr int DH = 16, DDH = 128, DLAT = 256, IH = 16, IDIM = 128, TOPK = 256;
constexpr int XH = 4, XDH = 512, DFF = 5632, INCOLS = 14752;
constexpr float EPS = 1e-6f;
constexpr int NWAVES = 8, NTHR = 512;

constexpr size_t MiB = 1u << 20;
constexpr size_t WS_CTL = 0, CTL_ZERO_BYTES = 32 * 1024;
constexpr size_t WS_BTUK = 1 * MiB;
constexpr size_t WS_BTUV = 3 * MiB;
constexpr size_t WS_MEMN = 5 * MiB;
constexpr size_t WS_CLAT = 7 * MiB;
constexpr size_t WS_KIDX = 15 * MiB;
constexpr size_t WS_IDX = 19 * MiB;
constexpr size_t WS_DCRAW = 27 * MiB;
constexpr size_t WS_MISC = 43 * MiB;
constexpr size_t WS_KV = 122 * MiB;
constexpr size_t WS_VT = 126 * MiB;
constexpr size_t WS_WXKV0 = 448 * MiB;
constexpr size_t WS_S1 = 64 * MiB, WS_S2 = 128 * MiB, WS_S3 = 192 * MiB, WS_S4 = 256 * MiB, WS_S5 = 320 * MiB, WS_S6 = 384 * MiB, WS_S7 = 448 * MiB, WS_END = 512 * MiB;
constexpr size_t WS_W1A = WS_S1;
constexpr size_t WS_W1B = WS_S1 + 18 * MiB;
constexpr size_t WS_SC = WS_S1;
constexpr size_t WS_WGB = WS_S1 + 8 * MiB, WS_WDB = WS_S1 + 16 * MiB, WS_WMIX = WS_S1 + 24 * MiB;
constexpr size_t WS_U0 = WS_S2;
constexpr size_t WS_QFP = WS_S2, WS_KDT = WS_S2 + 32 * MiB;
constexpr size_t WS_IQ = WS_S3;
constexpr size_t WS_DQ = WS_S4;
constexpr size_t WS_SCR = WS_S5;
constexpr size_t WS_GR = WS_S5, WS_GVT = WS_S6;
constexpr size_t WS_WXQ = WS_S6, WS_WXKV = WS_S6 + 8 * MiB, WS_WXO = WS_S6 + 24 * MiB;
constexpr size_t WS_YDSA = WS_S7;
constexpr size_t WS_WFGU = WS_S4;
constexpr size_t WS_WFD = WS_S4 + 44 * MiB;
constexpr size_t WS_HID = 328 * MiB;
static_assert(WS_HID + (size_t)M * DFF * 2 <= WS_END && WS_MISC + 16 * MiB <= 64 * MiB && WS_DCRAW + 16 * MiB <= WS_MISC && WS_IDX + 8 * MiB <= WS_DCRAW && WS_KIDX + 4 * MiB <= WS_IDX && WS_CLAT + 8 * MiB <= WS_KIDX, "ws map");
constexpr int CW_TMO = 0, CW_BAR = 4096;

constexpr int LDS_BYTES = 163840, MISC_OFF = LDS_BYTES - 256;

#define RLX_AGENT __ATOMIC_RELAXED, __HIP_MEMORY_SCOPE_AGENT
#define LDS_WAIT() asm volatile("s_waitcnt lgkmcnt(0)" ::: "memory")
#define VM_WAIT() asm volatile("s_waitcnt vmcnt(0)" ::: "memory")
typedef __bf16 bf16x2_t __attribute__((ext_vector_type(2)));
__device__ __forceinline__ unsigned cvt_pk_bf16(float lo, float hi) { const f32x2 v = {lo, hi}; const bf16x2_t b = __builtin_convertvector(v, bf16x2_t); return __builtin_bit_cast(unsigned, b); }
__device__ __forceinline__ float bf_lo(unsigned w) { return __uint_as_float(w << 16); }
__device__ __forceinline__ float bf_hi(unsigned w) { return __uint_as_float(w & 0xffff0000u); }
__device__ __forceinline__ float bf2f(bf16 h) { return __uint_as_float((unsigned)h << 16); }
__device__ __forceinline__ float sigmoidf_(float x) { return __frcp_rn(1.0f + __expf(-x)); }
__device__ __forceinline__ int fresh_lane() { unsigned z; asm volatile("v_mov_b32 %0, 0" : "=v"(z)); return (int)__builtin_amdgcn_mbcnt_hi(~0u, __builtin_amdgcn_mbcnt_lo(~0u, z)); }
template <int O> __device__ __forceinline__ float swz_(float v) { return __int_as_float(__builtin_amdgcn_ds_swizzle(__float_as_int(v), (O << 10) | 0x1F)); }
__device__ __forceinline__ float x32_sum(float v) { const auto r = __builtin_amdgcn_permlane32_swap(__float_as_uint(v), __float_as_uint(v), false, false); return __uint_as_float(r[0]) + __uint_as_float(r[1]); }
__device__ __forceinline__ float x32_max(float v) { const auto r = __builtin_amdgcn_permlane32_swap(__float_as_uint(v), __float_as_uint(v), false, false); return fmaxf(__uint_as_float(r[0]), __uint_as_float(r[1])); }
__device__ __forceinline__ float x16_sum(float v) { return v + swz_<16>(v); }
__device__ __forceinline__ float x16_max(float v) { return fmaxf(v, swz_<16>(v)); }
__device__ __forceinline__ float wave_sum(float v) {
    v += swz_<1>(v); v += swz_<2>(v); v += swz_<4>(v); v += swz_<8>(v); v += swz_<16>(v); return x32_sum(v);
}

namespace pg8 {
typedef unsigned short bf16_t;
constexpr int BM = 256, BK = 64, HALF = 128, HTB = HALF * BK * 2, STAGE_BYTES = 8 * HTB, NXCD = 8, WGM = 8;
__host__ __device__ __forceinline__ int lds_byte(int r, int c) { const int st = (r >> 4) * 2 + (c >> 5), rr = r & 15, cc = c & 31, ob = rr * 64 + cc * 2; return st * 1024 + (ob ^ (((ob >> 9) & 1) << 5)); }
__host__ __device__ __forceinline__ void stage_rc(int b, int& R, int& C) { const int st = b / 1024, sb = b % 1024, swz = sb ^ (((sb >> 9) & 1) << 5); R = (st >> 1) * 16 + swz / 64; C = (st & 1) * 32 + (swz % 64) / 2; }
__host__ __device__ __forceinline__ int perm32(int rho) { const int n = rho >> 4, i = rho & 15; return 8 * (i >> 2) + 4 * n + (i & 3); }

struct Unit { int pm, pn; };
struct Gemm { const bf16_t* A; const bf16_t* Bt; int M, N, K, lda, acs, ash; };

struct StaticOrder {
    int nM, nN, nwg, G, c;
    __host__ __device__ void init(int M_, int N_, int G_, int c_) { nM = M_ / BM; nN = N_ / BM; nwg = nM * nN; G = G_; c = c_; }
    __host__ __device__ bool next(int i, Unit& u) const {
        const long L = (long)i * G + c; if (L >= nwg) return false;
        int wgid = (int)L; { const int q = nwg / NXCD, r = nwg % NXCD, xcd = wgid % NXCD, off = wgid / NXCD; wgid = (xcd < r ? xcd * (q + 1) : r * (q + 1) + (xcd - r) * q) + off; }
        const int nig = WGM * nN, gid = wgid / nig, fm = gid * WGM, gsz = (nM - fm) < WGM ? (nM - fm) : WGM;
        u.pm = fm + ((wgid % nig) % gsz); u.pn = (wgid % nig) / gsz; return true;
    }
};

template <class Epi, class Sched, bool ALIGN_EPI = true>
__device__ __forceinline__ void gemm_phase(LAS unsigned char* lds, const Gemm g, const Sched& S, const Epi& E, const int wid) {
    const int lane = fresh_lane(), tid = wid * 64 + lane, wr = wid >> 2, wc = wid & 3, fr = lane & 15, fq = lane >> 4;
    const int K = g.K, nt = K / BK, lda = g.lda;
    unsigned voffA[2], voffB[2];
#pragma unroll
    for (int i = 0; i < 2; ++i) { int R, C; stage_rc(tid * 16 + i * 8192, R, C); const int Rb = (R & ~31) + perm32(R & 31);
        voffA[i] = (unsigned)(R * lda + C) * 2u; voffB[i] = (unsigned)(Rb * K + C) * 2u; }
    const size_t kstep = (size_t)(BK * 2);
    const size_t hstepA = (size_t)HALF * lda * 2, hstepB = (size_t)HALF * K * 2;
    const size_t tstepA = 2 * hstepA, tstepB = 2 * hstepB;
    const unsigned ldsw = (unsigned)wid * 1024u;
    const int aoff = lds_byte(wr * 64 + fr, fq * 8), boff = lds_byte(wc * 32 + fr, fq * 8);
#define PG8_SA(b, h) (((b) * 2 + (h)) * HTB)
#define PG8_SB(b, h) ((4 + (b) * 2 + (h)) * HTB)
#define PG8_STAGE(bufoff, gbase, voff) do { _Pragma("unroll") for (int _i = 0; _i < 2; ++_i) \
        __builtin_amdgcn_global_load_lds((const unsigned*)((const char*)(gbase) + (voff)[_i]), (LAS unsigned*)(lds + (bufoff) + ldsw + _i * 8192), 16, 0, 0); } while (0)
#define PG8_LDA(dst, b, h) do { _Pragma("unroll") for (int m = 0; m < 4; ++m) _Pragma("unroll") for (int k = 0; k < 2; ++k) dst[m][k] = *(const LAS bf16x8*)(lds + PG8_SA(b, h) + aoff + m * 2048 + k * 1024); } while (0)
#define PG8_LDB(dst, b, h) do { _Pragma("unroll") for (int n = 0; n < 2; ++n) _Pragma("unroll") for (int k = 0; k < 2; ++k) dst[n][k] = *(const LAS bf16x8*)(lds + PG8_SB(b, h) + boff + n * 2048 + k * 1024); } while (0)
#define PG8_MMA(ai, bj, At, Bt) do { __builtin_amdgcn_s_setprio(1); _Pragma("unroll") for (int m = 0; m < 4; ++m) _Pragma("unroll") for (int n = 0; n < 2; ++n) _Pragma("unroll") for (int k = 0; k < 2; ++k) \
        acc[ai][bj][m][n] = __builtin_amdgcn_mfma_f32_16x16x32_bf16(Bt[n][k], At[m][k], acc[ai][bj][m][n], 0, 0, 0); __builtin_amdgcn_s_setprio(0); } while (0)
#define PG8_WAIT_V(n) asm volatile("s_waitcnt vmcnt(" #n ")" ::: "memory")
#define PG8_WAIT_L(n) asm volatile("s_waitcnt lgkmcnt(" #n ")" ::: "memory")
#define PG8_BAR __builtin_amdgcn_s_barrier()
#define PG8_SCHED __builtin_amdgcn_sched_barrier(0)
    Unit cur, nxt; int ui = 0;
    if (!S.next(0, cur)) return;
    f32x4 acc[2][2][4][2];
#pragma unroll
    for (int a = 0; a < 2; ++a)
#pragma unroll
        for (int b = 0; b < 2; ++b)
#pragma unroll
            for (int m = 0; m < 4; ++m)
#pragma unroll
                for (int n = 0; n < 2; ++n) acc[a][b][m][n] = (f32x4){0.f, 0.f, 0.f, 0.f};
    bf16x8 At[4][2], B0[2][2], B1[2][2];
    const char* cA = (const char*)g.A + (size_t)cur.pm * tstepA + (size_t)((cur.pn >> g.ash) * g.acs) * 2; const char* cB = (const char*)g.Bt + (size_t)cur.pn * tstepB;
    PG8_STAGE(PG8_SB(0, 0), cB, voffB); PG8_STAGE(PG8_SB(0, 1), cB + hstepB, voffB); PG8_STAGE(PG8_SA(0, 0), cA, voffA); PG8_STAGE(PG8_SA(0, 1), cA + hstepA, voffA);
    if (wr == 1) PG8_BAR;
    PG8_WAIT_V(2); PG8_BAR;
    PG8_STAGE(PG8_SB(1, 0), cB + kstep, voffB); PG8_STAGE(PG8_SA(1, 0), cA + kstep, voffA); PG8_STAGE(PG8_SB(1, 1), cB + hstepB + kstep, voffB);
    PG8_WAIT_V(6); PG8_BAR;
    for (;;) {
        const bool has_next = S.next(ui + 1, nxt);
        const char* nA = has_next ? (const char*)g.A + (size_t)nxt.pm * tstepA + (size_t)((nxt.pn >> g.ash) * g.acs) * 2 : cA; const char* nB = has_next ? (const char*)g.Bt + (size_t)nxt.pn * tstepB : cB;
#pragma unroll 1
        for (int t = 0; t < nt; t += 2) {
            const bool last = (t == nt - 2);
            const char* a1 = cA + (size_t)(t + 1) * kstep;
            const char* a2 = last ? nA : cA + (size_t)(t + 2) * kstep; const char* b2 = last ? nB : cB + (size_t)(t + 2) * kstep;
            const char* a3 = a2 + kstep; const char* b3 = b2 + kstep;
            PG8_LDB(B0, 0, 0); PG8_LDB(B1, 0, 1); PG8_SCHED; PG8_LDA(At, 0, 0); PG8_STAGE(PG8_SA(1, 1), a1 + hstepA, voffA);
            PG8_WAIT_V(8); PG8_WAIT_L(0); PG8_BAR; PG8_MMA(0, 0, At, B0); PG8_MMA(0, 1, At, B1); PG8_BAR; PG8_SCHED;
            PG8_LDA(At, 0, 1); PG8_STAGE(PG8_SB(0, 0), b2, voffB); PG8_STAGE(PG8_SB(0, 1), b2 + hstepB, voffB); PG8_STAGE(PG8_SA(0, 0), a2, voffA);
            PG8_WAIT_V(8); PG8_WAIT_L(0); PG8_BAR; PG8_MMA(1, 0, At, B0); PG8_MMA(1, 1, At, B1); PG8_BAR; PG8_SCHED;
            PG8_LDB(B0, 1, 0); PG8_LDB(B1, 1, 1); PG8_SCHED; PG8_LDA(At, 1, 0); PG8_STAGE(PG8_SA(0, 1), a2 + hstepA, voffA);
            PG8_WAIT_V(8); PG8_WAIT_L(0); PG8_BAR; PG8_MMA(0, 0, At, B0); PG8_MMA(0, 1, At, B1); PG8_BAR; PG8_SCHED;
            PG8_LDA(At, 1, 1); PG8_STAGE(PG8_SB(1, 0), b3, voffB); PG8_STAGE(PG8_SB(1, 1), b3 + hstepB, voffB); PG8_STAGE(PG8_SA(1, 0), a3, voffA);
            PG8_WAIT_V(8); PG8_WAIT_L(0); PG8_BAR; PG8_MMA(1, 0, At, B0); PG8_MMA(1, 1, At, B1); PG8_BAR; PG8_SCHED;
        }
        if constexpr (ALIGN_EPI) { if (wr == 0) PG8_BAR; }
        E(acc, cur, wr, wc, fr, fq);
        if (!has_next) break;
#pragma unroll
        for (int a = 0; a < 2; ++a)
#pragma unroll
            for (int b = 0; b < 2; ++b)
#pragma unroll
                for (int m = 0; m < 4; ++m)
#pragma unroll
                    for (int n = 0; n < 2; ++n) acc[a][b][m][n] = (f32x4){0.f, 0.f, 0.f, 0.f};
        cur = nxt; cA = nA; cB = nB; ++ui;
        if constexpr (ALIGN_EPI) { if (wr == 1) PG8_BAR; }
    }
    PG8_WAIT_V(0);
    if constexpr (!ALIGN_EPI) { if (wr == 0) PG8_BAR; }
    PG8_BAR;
#undef PG8_SA
#undef PG8_SB
#undef PG8_STAGE
#undef PG8_LDA
#undef PG8_LDB
#undef PG8_MMA
#undef PG8_WAIT_V
#undef PG8_WAIT_L
#undef PG8_BAR
#undef PG8_SCHED
}

#define EPI_LOOP_BEGIN const int row0 = u.pm * BM + wr * 64 + fr; const int cl = wc * 32 + 8 * fq; \
    _Pragma("unroll") for (int ai = 0; ai < 2; ++ai) _Pragma("unroll") for (int m = 0; m < 4; ++m) { const size_t row = (size_t)(row0 + ai * HALF + m * 16);
#define EPI_LOOP_END }
__device__ __forceinline__ u32x4 pack8(const f32x4 v0, const f32x4 v1) { u32x4 w; w.x = cvt_pk_bf16(v0[0], v0[1]); w.y = cvt_pk_bf16(v0[2], v0[3]); w.z = cvt_pk_bf16(v1[0], v1[1]); w.w = cvt_pk_bf16(v1[2], v1[3]); return w; }

struct EpiPlain {
    bf16_t* O; int ldc;
    __device__ __forceinline__ void operator()(const f32x4 (&acc)[2][2][4][2], const Unit& u, int wr, int wc, int fr, int fq) const {
        EPI_LOOP_BEGIN
            bf16_t* rp = O + row * ldc + u.pn * BM + cl;
#pragma unroll
            for (int bj = 0; bj < 2; ++bj) *(u32x4*)(rp + bj * HALF) = pack8(acc[ai][bj][m][0], acc[ai][bj][m][1]);
        EPI_LOOP_END
    }
};
struct EpiP1a {
    bf16_t* iq; bf16_t* dq; float* dc; float* misc;
    __device__ __forceinline__ void operator()(const f32x4 (&acc)[2][2][4][2], const Unit& u, int wr, int wc, int fr, int fq) const {
        if (u.pn < 16) {
            bf16_t* base = (u.pn < 8) ? iq : dq; const int ct = (u.pn & 7) * BM;
            EPI_LOOP_BEGIN
                bf16_t* rp = base + row * DM + ct + cl;
#pragma unroll
                for (int bj = 0; bj < 2; ++bj) *(u32x4*)(rp + bj * HALF) = pack8(acc[ai][bj][m][0], acc[ai][bj][m][1]);
            EPI_LOOP_END
        } else {
            float* base = (u.pn == 16) ? dc : misc;
            EPI_LOOP_BEGIN
                float* rp = base + row * 256 + cl;
#pragma unroll
                for (int bj = 0; bj < 2; ++bj) { *(f32x4*)(rp + bj * HALF) = acc[ai][bj][m][0]; *(f32x4*)(rp + bj * HALF + 4) = acc[ai][bj][m][1]; }
            EPI_LOOP_END
        }
    }
};
struct EpiP1b {
    bf16_t* gqk; bf16_t* gv; bf16_t* gr; bf16_t* sg; bf16_t* sd;
    __device__ __forceinline__ void operator()(const f32x4 (&acc)[2][2][4][2], const Unit& u, int wr, int wc, int fr, int fq) const {
        const int seg = u.pn >> 3; const int ct = (u.pn & 7) * BM;
        bf16_t* base = seg == 0 ? gqk : seg == 1 ? gv : seg == 2 ? gr : seg == 3 ? sg : sd;
        const bool sig = seg >= 3;
        EPI_LOOP_BEGIN
            bf16_t* rp = base + row * DM + ct + cl;
#pragma unroll
            for (int bj = 0; bj < 2; ++bj) { f32x4 v0 = acc[ai][bj][m][0], v1 = acc[ai][bj][m][1];
                if (sig) {
#pragma unroll
                    for (int e = 0; e < 4; ++e) { v0[e] = sigmoidf_(v0[e]); v1[e] = sigmoidf_(v1[e]); } }
                *(u32x4*)(rp + bj * HALF) = pack8(v0, v1); }
        EPI_LOOP_END
    }
};
struct EpiGateMul {
    bf16_t* Gt;
    __device__ __forceinline__ void operator()(const f32x4 (&acc)[2][2][4][2], const Unit& u, int wr, int wc, int fr, int fq) const {
        EPI_LOOP_BEGIN
            bf16_t* rp = Gt + row * DM + u.pn * BM + cl;
#pragma unroll
            for (int bj = 0; bj < 2; ++bj) { const u32x4 gg = *(const u32x4*)(rp + bj * HALF); f32x4 v0 = acc[ai][bj][m][0], v1 = acc[ai][bj][m][1];
                v0[0] *= bf_lo(gg.x); v0[1] *= bf_hi(gg.x); v0[2] *= bf_lo(gg.y); v0[3] *= bf_hi(gg.y); v1[0] *= bf_lo(gg.z); v1[1] *= bf_hi(gg.z); v1[2] *= bf_lo(gg.w); v1[3] *= bf_hi(gg.w);
                *(u32x4*)(rp + bj * HALF) = pack8(v0, v1); }
        EPI_LOOP_END
    }
};
struct EpiMerge {
    const bf16_t* SG; const bf16_t* T; bf16_t* O;
    __device__ __forceinline__ void operator()(const f32x4 (&acc)[2][2][4][2], const Unit& u, int wr, int wc, int fr, int fq) const {
        EPI_LOOP_BEGIN
            const size_t o = row * DM + u.pn * BM + cl;
#pragma unroll
            for (int bj = 0; bj < 2; ++bj) { const u32x4 gg = *(const u32x4*)(SG + o + bj * HALF); const u32x4 tt = *(const u32x4*)(T + o + bj * HALF); f32x4 v0 = acc[ai][bj][m][0], v1 = acc[ai][bj][m][1];
                v0[0] = v0[0] * bf_lo(gg.x) + bf_lo(tt.x); v0[1] = v0[1] * bf_hi(gg.x) + bf_hi(tt.x); v0[2] = v0[2] * bf_lo(gg.y) + bf_lo(tt.y); v0[3] = v0[3] * bf_hi(gg.y) + bf_hi(tt.y);
                v1[0] = v1[0] * bf_lo(gg.z) + bf_lo(tt.z); v1[1] = v1[1] * bf_hi(gg.z) + bf_hi(tt.z); v1[2] = v1[2] * bf_lo(gg.w) + bf_lo(tt.w); v1[3] = v1[3] * bf_hi(gg.w) + bf_hi(tt.w);
                *(u32x4*)(O + o + bj * HALF) = pack8(v0, v1); }
        EPI_LOOP_END
    }
};
struct EpiSwiglu {
    bf16_t* H;
    __device__ __forceinline__ void operator()(const f32x4 (&acc)[2][2][4][2], const Unit& u, int wr, int wc, int fr, int fq) const {
        EPI_LOOP_BEGIN
            f32x4 v0, v1;
#pragma unroll
            for (int e = 0; e < 4; ++e) { const float g0 = acc[ai][0][m][0][e], g1 = acc[ai][0][m][1][e];
                v0[e] = g0 * sigmoidf_(g0) * acc[ai][1][m][0][e]; v1[e] = g1 * sigmoidf_(g1) * acc[ai][1][m][1][e]; }
            *(u32x4*)(H + row * DFF + u.pn * HALF + cl) = pack8(v0, v1);
        EPI_LOOP_END
    }
};
}

#define XB_TMO      128
#define XB_XCNT(j)  (256  + 64 * (j))
#define XB_XSUB(j)  (1280 + 64 * (j))
#define XB_XGEN(j)  (2304 + 64 * (j))
#define XB_TOP      3328
#define XB_TOPGEN   3392
#define XCD_BAR_WORDS 3456
#define XB_SPIN_CAP (1u << 22)
__device__ __forceinline__ unsigned xb_ld(unsigned* p)              { return __hip_atomic_load(p, __ATOMIC_RELAXED, __HIP_MEMORY_SCOPE_AGENT); }
__device__ __forceinline__ unsigned xb_add(unsigned* p, unsigned v) { return __hip_atomic_fetch_add(p, v, __ATOMIC_RELAXED, __HIP_MEMORY_SCOPE_AGENT); }
__device__ __forceinline__ unsigned xb_xcc_id() { return (unsigned)__builtin_amdgcn_s_getreg((3 << 11) | 20) & 0xFu; }
#define XB_SPIN(cond, bar) do { unsigned _sp = 0; while (cond) { __builtin_amdgcn_s_sleep(1); \
    if ((++_sp & 255u) == 0u) { if (xb_ld(&(bar)[XB_TMO])) break; if (_sp > XB_SPIN_CAP) { atomicAdd(&(bar)[XB_TMO], 1u); break; } } } } while (0)
struct XcdBarrier { unsigned* bar; unsigned x; volatile LAS unsigned* st; int wave; };
__device__ __forceinline__ bool xb_thread0(int wave) { return wave == 0 && fresh_lane() == 0; }
__device__ __forceinline__ XcdBarrier xcd_barrier_post(unsigned* bar, volatile LAS unsigned* st, int wave) {
    XcdBarrier b; b.bar = bar; b.x = xb_xcc_id(); b.st = st; b.wave = wave;
    if (xb_thread0(b.wave)) (void)xb_add(&bar[XB_XCNT(b.x)], 1u);
    return b;
}
__device__ __forceinline__ void xcd_barrier_complete(unsigned* bar, unsigned x, unsigned& nloc, unsigned& nx) {
    const unsigned G = gridDim.x * gridDim.y * gridDim.z;
    unsigned sum, cnt, mine, sp = 0u;
    for (;;) {
        sum = 0u; cnt = 0u; mine = 0u;
#pragma unroll
        for (unsigned j = 0; j < 16; ++j) { const unsigned c = xb_ld(&bar[XB_XCNT(j)]); sum += c; cnt += (c > 0u) ? 1u : 0u; mine = (j == x) ? c : mine; }
        if (sum == G) break;
        __builtin_amdgcn_s_sleep(1);
        if ((++sp & 255u) == 0u) { if (xb_ld(&bar[XB_TMO])) break; if (sp > XB_SPIN_CAP) { atomicAdd(&bar[XB_TMO], 1u); break; } }
    }
    nloc = mine > 0u ? mine : 1u; nx = cnt > 0u ? cnt : 1u;
}
#ifndef BAR_SCOPE
#define BAR_SCOPE "agent"
#endif
__device__ __forceinline__ void xcd_barrier(const XcdBarrier& b) {
    asm volatile("s_waitcnt vmcnt(0)" ::: "memory");
    __syncthreads();
    if (xb_thread0(b.wave)) {
        unsigned* bar = b.bar;
        __builtin_amdgcn_s_waitcnt(0);
        unsigned nloc = b.st[0], nx = b.st[1];
        if (nloc == 0u) { xcd_barrier_complete(bar, b.x, nloc, nx); b.st[0] = nloc; b.st[1] = nx; }
        const unsigned old = xb_add(&bar[XB_XSUB(b.x)], 1u);
        const unsigned gen = old / nloc;
        if (old + 1u == (gen + 1u) * nloc) {
            __builtin_amdgcn_fence(__ATOMIC_RELEASE, BAR_SCOPE);
            asm volatile("s_waitcnt vmcnt(0)" ::: "memory");
            const unsigned og = xb_add(&bar[XB_TOP], 1u);
            const unsigned tg = og / nx;
            if (og + 1u == (tg + 1u) * nx) xb_add(&bar[XB_TOPGEN], 1u);
            else XB_SPIN(xb_ld(&bar[XB_TOPGEN]) == tg, bar);
            __builtin_amdgcn_fence(__ATOMIC_ACQUIRE, BAR_SCOPE);
            xb_add(&bar[XB_XGEN(b.x)], 1u);
            asm volatile("s_waitcnt vmcnt(0)" ::: "memory");
        } else {
            XB_SPIN(xb_ld(&bar[XB_XGEN(b.x)]) == gen, bar);
            __builtin_amdgcn_fence(__ATOMIC_ACQUIRE, BAR_SCOPE);
            asm volatile("s_waitcnt vmcnt(0)" ::: "memory");
        }
    }
    __syncthreads();
}

struct Params { const float* in[28]; float* out; unsigned char* ws; };
#define KARG_IN(i) (*(const float* const volatile __attribute__((address_space(4)))*)((const __attribute__((address_space(4))) char*)__builtin_amdgcn_kernarg_segment_ptr() + 8 * (i)))

enum { I_X = 0, I_MEM, I_WIN, I_WA2, I_BA, I_GONORM, I_WUK, I_WUV, I_LATNORM, I_IKW, I_IKB, I_RELB, I_WGB, I_WDB, I_WMIX, I_MIXPRE, I_MIXPOST, I_XAPRE, I_XAPOST, I_XAMEM,
       I_WXQ, I_WXKV, I_WXO, I_FFPRE, I_FFPOST, I_WFG, I_WFU, I_WFD };

__device__ __forceinline__ void conv_item(const float* W, int ldw, int c0, int ncols, bf16* dst, int dk, int koff, int r0, LAS float* scr, int item, int lane) {
    const int nblk = (ncols + 63) >> 6, kb = item / nblk, nb = item - kb * nblk, k0 = 64 * kb, n0 = 64 * nb, nv = ncols - n0;
    const int c4 = lane & 15, r = lane >> 4;
    LAS unsigned char* t = (LAS unsigned char*)scr;
    f32x4 v[16];
    const float* src = W + (size_t)(k0 + 16 * r) * ldw + c0 + n0 + 4 * c4;
    if (4 * c4 < nv) {
#pragma unroll
        for (int i = 0; i < 16; ++i) v[i] = *(const f32x4*)(src + (size_t)i * ldw);
    } else {
#pragma unroll
        for (int i = 0; i < 16; ++i) v[i] = (f32x4){0.f, 0.f, 0.f, 0.f};
    }
#pragma unroll
    for (int e = 0; e < 4; ++e) {
        u32x4 a, b;
        a.x = cvt_pk_bf16(v[0][e], v[1][e]); a.y = cvt_pk_bf16(v[2][e], v[3][e]); a.z = cvt_pk_bf16(v[4][e], v[5][e]); a.w = cvt_pk_bf16(v[6][e], v[7][e]);
        b.x = cvt_pk_bf16(v[8][e], v[9][e]); b.y = cvt_pk_bf16(v[10][e], v[11][e]); b.z = cvt_pk_bf16(v[12][e], v[13][e]); b.w = cvt_pk_bf16(v[14][e], v[15][e]);
        *(LAS u32x4*)(t + (4 * c4 + e) * 144 + r * 32) = a; *(LAS u32x4*)(t + (4 * c4 + e) * 144 + r * 32 + 16) = b;
    }
    LDS_WAIT();
    const int ch = lane & 7;
#pragma unroll
    for (int j = 0; j < 8; ++j) { const int n = (lane >> 3) + 8 * j; const u32x4 o = *(const LAS u32x4*)(t + n * 144 + ch * 16);
        if (n < nv) *(GAS u32x4*)(dst + (size_t)(r0 + n0 + n) * dk + koff + k0 + 8 * ch) = o; }
    LDS_WAIT();
}
__device__ __forceinline__ void conv_seg(const float* W, int ldw, int K, int c0, int ncols, bf16* dst, int dk, int koff, int r0, LAS float* scr, int gw, int NGW, int lane, int& rot) {
    const int items = (K >> 6) * ((ncols + 63) >> 6);
    int st = gw - rot; if (st < 0) st += NGW;
    for (int it = st; it < items; it += NGW) conv_item(W, ldw, c0, ncols, dst, dk, koff, r0, scr, it, lane);
    rot = (rot + items) % NGW;
}

__device__ __forceinline__ void rms_row_to_bf16(const float* xrow, const float* gain, bf16* orow, int lane) {
    const f32x4* xr = (const f32x4*)xrow + lane; const f32x4* gr = (const f32x4*)gain + lane;
    f32x4 v[8]; float s = 0.f;
#pragma unroll
    for (int j = 0; j < 8; ++j) { v[j] = xr[64 * j]; s += (v[j].x * v[j].x + v[j].y * v[j].y) + (v[j].z * v[j].z + v[j].w * v[j].w); }
    const float rstd = rsqrtf(wave_sum(s) * (1.f / DM) + EPS);
    u32x2* o8 = (u32x2*)orow + lane;
#pragma unroll
    for (int j = 0; j < 8; ++j) { const f32x4 g = gr[64 * j]; u32x2 w; w.x = cvt_pk_bf16(v[j].x * rstd * g.x, v[j].y * rstd * g.y); w.y = cvt_pk_bf16(v[j].z * rstd * g.z, v[j].w * rstd * g.w); o8[64 * j] = w; }
}
__device__ __forceinline__ void rms_rows2_to_bf16(const float* xa, const float* xb, const float* gain, bf16* oa, bf16* ob, int lane) {
    const f32x4* gr = (const f32x4*)gain + lane;
    f32x4 va[8], vb[8], g[8];
#pragma unroll
    for (int j = 0; j < 8; ++j) va[j] = ((const f32x4*)xa + lane)[64 * j];
#pragma unroll
    for (int j = 0; j < 8; ++j) vb[j] = ((const f32x4*)xb + lane)[64 * j];
#pragma unroll
    for (int j = 0; j < 8; ++j) g[j] = gr[64 * j];
    __builtin_amdgcn_sched_barrier(0);
    float sa = 0.f, sb = 0.f;
#pragma unroll
    for (int j = 0; j < 8; ++j) { sa += (va[j].x * va[j].x + va[j].y * va[j].y) + (va[j].z * va[j].z + va[j].w * va[j].w); sb += (vb[j].x * vb[j].x + vb[j].y * vb[j].y) + (vb[j].z * vb[j].z + vb[j].w * vb[j].w); }
    const float ra = rsqrtf(wave_sum(sa) * (1.f / DM) + EPS), rb = rsqrtf(wave_sum(sb) * (1.f / DM) + EPS);
#pragma unroll
    for (int j = 0; j < 8; ++j) { u32x2 w; w.x = cvt_pk_bf16(va[j].x * ra * g[j].x, va[j].y * ra * g[j].y); w.y = cvt_pk_bf16(va[j].z * ra * g[j].z, va[j].w * ra * g[j].w); ((u32x2*)oa + lane)[64 * j] = w; }
#pragma unroll
    for (int j = 0; j < 8; ++j) { u32x2 w; w.x = cvt_pk_bf16(vb[j].x * rb * g[j].x, vb[j].y * rb * g[j].y); w.y = cvt_pk_bf16(vb[j].z * rb * g[j].z, vb[j].w * rb * g[j].w); ((u32x2*)ob + lane)[64 * j] = w; }
}
template <bool HIN_BF, bool HOUT_BF, int NR> __device__ __forceinline__ void resid_rows(const void* hold, const bf16* ybase, const float* gpost, void* hout, const float* gpre, bf16* ubase, size_t m0, size_t rstep, int lane) {
    u32x2 yw[NR][8]; u32x2 hw[NR][8]; f32x4 hf[NR][8]; f32x4 gq[8];
#pragma unroll
    for (int r = 0; r < NR; ++r) { const size_t m = m0 + r * rstep;
#pragma unroll
        for (int j = 0; j < 8; ++j) yw[r][j] = ((const u32x2*)(ybase + m * DM) + lane)[64 * j]; }
#pragma unroll
    for (int r = 0; r < NR; ++r) { const size_t m = m0 + r * rstep;
#pragma unroll
        for (int j = 0; j < 8; ++j) { if (HIN_BF) hw[r][j] = ((const u32x2*)((const bf16*)hold + m * DM) + lane)[64 * j]; else hf[r][j] = ((const f32x4*)((const float*)hold + m * DM) + lane)[64 * j]; } }
#pragma unroll
    for (int j = 0; j < 8; ++j) gq[j] = ((const f32x4*)gpost + lane)[64 * j];
    __builtin_amdgcn_sched_barrier(0);
    f32x4 y[NR][8]; float rstd[NR];
#pragma unroll
    for (int r = 0; r < NR; ++r) { float s = 0.f;
#pragma unroll
        for (int j = 0; j < 8; ++j) { const u32x2 w = yw[r][j]; y[r][j] = (f32x4){bf_lo(w.x), bf_hi(w.x), bf_lo(w.y), bf_hi(w.y)}; s += (y[r][j].x * y[r][j].x + y[r][j].y * y[r][j].y) + (y[r][j].z * y[r][j].z + y[r][j].w * y[r][j].w); }
        rstd[r] = rsqrtf(wave_sum(s) * (1.f / DM) + EPS); }
    float r2[NR];
#pragma unroll
    for (int r = 0; r < NR; ++r) { const size_t m = m0 + r * rstep; float s2 = 0.f;
#pragma unroll
        for (int j = 0; j < 8; ++j) { f32x4 h;
            if (HIN_BF) { const u32x2 w = hw[r][j]; h = (f32x4){bf_lo(w.x), bf_hi(w.x), bf_lo(w.y), bf_hi(w.y)}; } else h = hf[r][j];
            y[r][j] = h + y[r][j] * rstd[r] * gq[j]; s2 += (y[r][j].x * y[r][j].x + y[r][j].y * y[r][j].y) + (y[r][j].z * y[r][j].z + y[r][j].w * y[r][j].w); }
#pragma unroll
        for (int j = 0; j < 8; ++j) {
            if (HOUT_BF) { u32x2 w; w.x = cvt_pk_bf16(y[r][j].x, y[r][j].y); w.y = cvt_pk_bf16(y[r][j].z, y[r][j].w); ((u32x2*)((bf16*)hout + m * DM) + lane)[64 * j] = w; } else ((f32x4*)((float*)hout + m * DM) + lane)[64 * j] = y[r][j]; }
        r2[r] = s2; }
    if (ubase) {
#pragma unroll
        for (int j = 0; j < 8; ++j) gq[j] = ((const f32x4*)gpre + lane)[64 * j];
#pragma unroll
        for (int r = 0; r < NR; ++r) { const size_t m = m0 + r * rstep; const float rr = rsqrtf(wave_sum(r2[r]) * (1.f / DM) + EPS); u32x2* o8 = (u32x2*)(ubase + m * DM) + lane;
#pragma unroll
            for (int j = 0; j < 8; ++j) { const f32x4 g = gq[j]; u32x2 w; w.x = cvt_pk_bf16(y[r][j].x * rr * g.x, y[r][j].y * rr * g.y); w.y = cvt_pk_bf16(y[r][j].z * rr * g.z, y[r][j].w * rr * g.w); o8[64 * j] = w; } }
    }
}

struct Frame {
    LAS unsigned char* lds;
    int tid, lane, wave, bid, G;
};

__device__ __forceinline__ void p0_prologue(const Params& p, const Frame& F) {
    LAS float* scr = (LAS float*)(F.lds + F.wave * 16384);
    const int gw = F.bid * NWAVES + F.wave, NGW = F.G * NWAVES, lane = F.lane;
    unsigned char* ws = p.ws;
    const float* win = KARG_IN(I_WIN);
    int rot = 0;
    bf16* w1a = (bf16*)(ws + WS_W1A); bf16* w1b = (bf16*)(ws + WS_W1B);
    conv_seg(win, INCOLS, DM, 8464, 2048, w1a, DM, 0, 0, scr, gw, NGW, lane, rot);
    conv_seg(win, INCOLS, DM, 6160, 2048, w1a, DM, 0, 2048, scr, gw, NGW, lane, rot);
    conv_seg(win, INCOLS, DM, 8208, 256, w1a, DM, 0, 4096, scr, gw, NGW, lane, rot);
    conv_seg(win, INCOLS, DM, 10512, 128, w1a, DM, 0, 4352, scr, gw, NGW, lane, rot);
    conv_seg(win, INCOLS, DM, 10640, 16, w1a, DM, 0, 4480, scr, gw, NGW, lane, rot);
    conv_seg(win, INCOLS, DM, 6144, 16, w1a, DM, 0, 4496, scr, gw, NGW, lane, rot);
    { u32x4* z = (u32x4*)(w1a + (size_t)4512 * DM); const int nz = 96 * DM * 2 / 16; for (int i = gw * 64 + lane; i < nz; i += NGW * 64) z[i] = (u32x4){0u, 0u, 0u, 0u}; }
    conv_seg(KARG_IN(I_WXKV), 2 * DM, DM, 0, 2 * DM, (bf16*)(ws + WS_WXKV0), DM, 0, 0, scr, gw, NGW, lane, rot);
    { bf16* u0 = (bf16*)(ws + WS_U0); for (int m = gw; m < M; m += 2 * NGW) { if (m + NGW < M) rms_rows2_to_bf16(KARG_IN(I_X) + (size_t)m * DM, KARG_IN(I_X) + (size_t)(m + NGW) * DM, KARG_IN(I_MIXPRE), u0 + (size_t)m * DM, u0 + (size_t)(m + NGW) * DM, lane); else rms_row_to_bf16(KARG_IN(I_X) + (size_t)m * DM, KARG_IN(I_MIXPRE), u0 + (size_t)m * DM, lane); } }
    { bf16* mn = (bf16*)(ws + WS_MEMN); int st = gw - rot; if (st < 0) st += NGW; for (int m = st; m < NB * NMEM; m += NGW) rms_row_to_bf16(KARG_IN(I_MEM) + (size_t)m * DM, KARG_IN(I_XAMEM), mn + (size_t)m * DM, lane); }
}

__device__ __forceinline__ void p0_late(const Params& p, const Frame& F, int gw, int NGW) {
    LAS float* scr = (LAS float*)(F.lds + F.wave * 16384);
    const int lane = F.lane;
    unsigned char* ws = p.ws;
    const float* win = KARG_IN(I_WIN);
    bf16* w1b = (bf16*)(ws + WS_W1B);
    int rot = 0;
    conv_seg(win, INCOLS, DM, 0, 6144, w1b, DM, 0, 0, scr, gw, NGW, lane, rot);
    conv_seg(win, INCOLS, DM, 10656, 4096, w1b, DM, 0, 6144, scr, gw, NGW, lane, rot);
    { bf16* d = (bf16*)(ws + WS_BTUK); const float* s = KARG_IN(I_WUK);
      for (int i = gw * 64 + lane; i < 4096 * 256; i += NGW * 64) { const int row = i >> 8, k = i & 255, h = row >> 8, r = row & 255;
          const float v = ((k >> 7) == (h & 1)) ? s[((size_t)h * 128 + (k & 127)) * 256 + r] : 0.f; d[i] = (bf16)(cvt_pk_bf16(v, 0.f) & 0xffffu); } }
    { bf16* d = (bf16*)(ws + WS_BTUV); const float* s = KARG_IN(I_WUV);
      for (int i = gw * 64 + lane; i < 2048 * 512; i += NGW * 64) { const int row = i >> 9, k = i & 511, hp = row >> 8, j = (row >> 7) & 1, v = row & 127;
          const float x = ((k >> 8) == j) ? s[((size_t)(2 * hp + j) * 256 + (k & 255)) * 128 + v] : 0.f; d[i] = (bf16)(cvt_pk_bf16(x, 0.f) & 0xffffu); } }
}

__device__ __forceinline__ void p2_norms(const Params& p, const Frame& F) {
    const int gw = F.bid * NWAVES + F.wave, NGW = F.G * NWAVES, lane = F.lane;
    const float* dc = (const float*)(p.ws + WS_DCRAW); const float* misc = (const float*)(p.ws + WS_MISC);
    bf16* clat = (bf16*)(p.ws + WS_CLAT); bf16* kidx = (bf16*)(p.ws + WS_KIDX);
    const f32x4 gl = ((const f32x4*)KARG_IN(I_LATNORM))[lane];
    const f32x2 kw = ((const f32x2*)KARG_IN(I_IKW))[lane], kb = ((const f32x2*)KARG_IN(I_IKB))[lane];
    for (int m0 = gw; m0 < M; m0 += 4 * NGW) {
        f32x4 v4[4]; f32x2 a4[4];
#pragma unroll
        for (int r = 0; r < 4; ++r) { const int m = m0 + r * NGW; if (m < M) { v4[r] = ((const f32x4*)(dc + (size_t)m * 256))[lane]; a4[r] = ((const f32x2*)(misc + (size_t)m * 256))[lane]; } else { v4[r] = (f32x4){0.f, 0.f, 0.f, 0.f}; a4[r] = (f32x2){0.f, 0.f}; } }
        __builtin_amdgcn_sched_barrier(0);
#pragma unroll
        for (int r = 0; r < 4; ++r) { const int m = m0 + r * NGW; if (m >= M) break;
            const f32x4 v = v4[r];
            const float ss = wave_sum((v.x * v.x + v.y * v.y) + (v.z * v.z + v.w * v.w));
            const float rstd = rsqrtf(ss * (1.f / 256.f) + EPS);
            u32x2 w; w.x = cvt_pk_bf16(v.x * rstd * gl.x, v.y * rstd * gl.y); w.y = cvt_pk_bf16(v.z * rstd * gl.z, v.w * rstd * gl.w);
            ((u32x2*)(clat + (size_t)m * 256))[lane] = w;
            const f32x2 a = a4[r];
            const float mu = wave_sum(a.x + a.y) * (1.f / 128.f);
            const float dx = a.x - mu, dy = a.y - mu;
            const float var = wave_sum(dx * dx + dy * dy) * (1.f / 128.f);
            const float r2 = rsqrtf(var + EPS);
            ((unsigned*)(kidx + (size_t)m * 128))[lane] = cvt_pk_bf16(dx * r2 * kw.x + kb.x, dy * r2 * kw.y + kb.y);
        }
    }
}

constexpr int IDX_KROW = 272;
constexpr int IDX_KBUF = 64 * IDX_KROW;
__device__ __forceinline__ int wave_incl_scan(int v) {
    v += __builtin_amdgcn_update_dpp(0, v, 0x111, 0xf, 0xf, true);
    v += __builtin_amdgcn_update_dpp(0, v, 0x112, 0xf, 0xf, true);
    v += __builtin_amdgcn_update_dpp(0, v, 0x114, 0xf, 0xf, true);
    v += __builtin_amdgcn_update_dpp(0, v, 0x118, 0xf, 0xf, true);
    v += __builtin_amdgcn_update_dpp(0, v, 0x142, 0xa, 0xf, false);
    v += __builtin_amdgcn_update_dpp(0, v, 0x143, 0xc, 0xf, false);
    return v;
}
constexpr int IDX_STG_OFF = 53248, IDX_STG_W = 1024;
static_assert(3 * IDX_KBUF <= IDX_STG_OFF && IDX_STG_OFF + 8 * IDX_STG_W <= MISC_OFF, "idx lds");
#define PK_SUBSAT(D, A, B) asm("v_pk_sub_u16 %0, %1, %2 clamp" : "=v"(D) : "v"(A), "s"(B))
#define PK_MIN(D, A, B) asm("v_pk_min_u16 %0, %1, %2" : "=v"(D) : "v"(A), "s"(B))
#define PK_ADD(D, A, B) asm("v_pk_add_u16 %0, %1, %2" : "=v"(D) : "v"(A), "v"(B))
__device__ __forceinline__ void idx_select_query(const unsigned* rowp, int L, u16* outp, int lane, LAS unsigned char* stg) {
    unsigned kp[64];
    int laneB = (lane >> 3) * 64 + 4 * (lane & 7); asm volatile("" : "+v"(laneB));
    const int nblk = (L + 1023) >> 10;
    const int vt = (L >> 6) - (lane >> 3);
#pragma unroll
    for (int blk = 0; blk < 8; ++blk) {
        if (blk < nblk) {
#pragma unroll
            for (int h = 0; h < 2; ++h) { const int r4 = 2 * blk + h; const u32x4 v = *(const u32x4*)(rowp + (r4 * 64 + lane) * 4);
                kp[4 * r4 + 0] = v.x; kp[4 * r4 + 1] = v.y; kp[4 * r4 + 2] = v.z; kp[4 * r4 + 3] = v.w; }
        }
    }
    typedef short s16x2v __attribute__((ext_vector_type(2)));
#pragma unroll
    for (int blk = 0; blk < 8; ++blk) {
        if (blk < nblk) {
#pragma unroll
            for (int r = blk * 8; r < blk * 8 + 8; ++r) {
                const unsigned pb = kp[r];
                const unsigned mneg = __builtin_bit_cast(unsigned, __builtin_bit_cast(s16x2v, pb) >> (short)15);
                const unsigned k = pb ^ (mneg | 0x80008000u);
                kp[r] = ((r >> 2) * 8 < vt) ? k : 0u;
            }
        } else {
#pragma unroll
            for (int r = blk * 8; r < blk * 8 + 8; ++r) kp[r] = 0u;
        }
    }
    const unsigned one2 = 0x00010001u;
    unsigned T = 0u;
    for (int bit = 15; bit >= 0; --bit) {
        const unsigned c16v = T | (1u << bit); const unsigned cm1 = (c16v - 1u) * 0x00010001u;
        unsigned a0 = 0u, a1 = 0u;
#pragma unroll
        for (int blk = 0; blk < 8; ++blk) {
            if (blk < nblk) {
#pragma unroll
                for (int r = blk * 8; r < blk * 8 + 8; r += 2) {
                    unsigned d0, d1;
                    PK_SUBSAT(d0, kp[r], cm1); PK_MIN(d0, d0, one2); PK_ADD(a0, a0, d0);
                    PK_SUBSAT(d1, kp[r + 1], cm1); PK_MIN(d1, d1, one2); PK_ADD(a1, a1, d1);
                }
            }
        }
        unsigned ap; PK_ADD(ap, a0, a1);
        const int cnt = __builtin_amdgcn_readlane(wave_incl_scan((int)((ap & 0xFFFFu) + (ap >> 16))), 63);
        if (cnt >= TOPK) T = c16v;
    }
    const unsigned Tpk = T * 0x00010001u;
    unsigned g0 = 0u, g1 = 0u, ne[4] = {0u, 0u, 0u, 0u};
#pragma unroll
    for (int blk = 0; blk < 8; ++blk) {
        if (blk < nblk) {
#pragma unroll
            for (int r = blk * 8; r < blk * 8 + 8; r += 2) {
                unsigned d0, d1, x0, x1;
                PK_SUBSAT(d0, kp[r], Tpk); PK_MIN(d0, d0, one2); PK_ADD(g0, g0, d0);
                PK_SUBSAT(d1, kp[r + 1], Tpk); PK_MIN(d1, d1, one2); PK_ADD(g1, g1, d1);
                x0 = kp[r] ^ Tpk; PK_MIN(x0, x0, one2); ne[r >> 4] |= x0 << (r & 15);
                x1 = kp[r + 1] ^ Tpk; PK_MIN(x1, x1, one2); ne[r >> 4] |= x1 << ((r + 1) & 15);
            }
        }
    }
    unsigned gp; PK_ADD(gp, g0, g1);
    const int ngt = (int)((gp & 0xFFFFu) + (gp >> 16));
    unsigned eq[4]; int neq = 0;
#pragma unroll
    for (int j = 0; j < 4; ++j) { const unsigned pm = (nblk >= 2 * j + 2) ? 0xFFFFFFFFu : (nblk == 2 * j + 1 ? 0x00FF00FFu : 0u); eq[j] = ~ne[j] & pm; neq += __builtin_popcount(eq[j]); }
    const int sg = wave_incl_scan(ngt), se = wave_incl_scan(neq);
    const int tot_gt = __builtin_amdgcn_readlane(sg, 63);
    LAS unsigned char* dump = stg + 2 * lane;
    LAS unsigned char* og = stg + 128 + 2 * (sg - ngt);
#pragma unroll
    for (int blk = 0; blk < 8; ++blk) {
        if (blk < nblk) {
#pragma unroll
            for (int r = blk * 8; r < blk * 8 + 8; ++r) {
#pragma unroll
                for (int hlf = 0; hlf < 2; ++hlf) {
                    const unsigned kv = hlf ? (kp[r] >> 16) : (kp[r] & 0xFFFFu);
                    const u16 id = (u16)(laneB + ((r >> 2) * 512 + (r & 3) + hlf * 32));
                    const bool tk = kv > T;
                    *(LAS u16*)(tk ? og : dump) = id;
                    og += tk ? 2 : 0;
                }
            }
        }
    }
    int oe = tot_gt + se - neq;
    while (true) {
        const unsigned any = eq[0] | eq[1] | eq[2] | eq[3];
        if (__builtin_amdgcn_ballot_w64(any != 0u) == 0ull) break;
        const int j = eq[0] ? 0 : (eq[1] ? 1 : (eq[2] ? 2 : 3));
        const unsigned m = eq[0] ? eq[0] : (eq[1] ? eq[1] : (eq[2] ? eq[2] : eq[3]));
        const int b = m ? __builtin_ctz(m) : 0;
        const int r = 16 * j + (b & 15);
        const u16 id = (u16)(laneB + ((r >> 2) * 512 + (r & 3) + (b >> 4) * 32));
        const bool tk = (any != 0u) && (oe < TOPK);
        *(LAS u16*)(tk ? (stg + 128 + 2 * oe) : dump) = id;
        oe += (any != 0u) ? 1 : 0;
        const unsigned clr = ~(m & (0u - m));
        if (j == 0) eq[0] &= clr; else if (j == 1) eq[1] &= clr; else if (j == 2) eq[2] &= clr; else eq[3] &= clr;
    }
    LDS_WAIT();
    if (outp) { const u32x2 ov = *(const LAS u32x2*)(stg + 128 + 8 * lane); *(u32x2*)(outp + 4 * lane) = ov; }
}

#ifndef SC_VAR
#define SC_VAR -1
#endif
#ifndef TP_REGION
#define TP_REGION 0
#endif
#define TPR_BEGIN(ID) unsigned long long tpr0_ = 0; if (TP_REGION == (ID)) tpr0_ = __builtin_amdgcn_s_memrealtime()
#ifndef TP_WAVE
#define TP_WAVE 0
#endif
#define TPR_END(ID) do { if (TP_REGION == (ID) && F.wave == TP_WAVE && fresh_lane() == 0) { LAS unsigned* M_ = (LAS unsigned*)(F.lds + MISC_OFF); M_[20] = M_[20] + (unsigned)(__builtin_amdgcn_s_memrealtime() - tpr0_); } } while (0)
#if SC_VAR >= 0
#define IDX_SCORE_EXTRA() do { __syncthreads(); const unsigned long long tp0_ = __builtin_amdgcn_s_memrealtime(); idx_score_unit<SC_VAR>(F, iq, kidx, misc, scr, mb, t0, L); __syncthreads(); \
        if (F.wave == 0 && fresh_lane() == 0) { LAS unsigned* M_ = (LAS unsigned*)(F.lds + MISC_OFF); M_[20] = M_[20] + (unsigned)(__builtin_amdgcn_s_memrealtime() - tp0_); } } while (0)
#else
#define IDX_SCORE_EXTRA() do { } while (0)
#endif
template <int VAR> __device__ __forceinline__ void idx_score_unit(const Frame& F, const bf16* iq, const bf16* kidx, const float* misc, f16* scr, const size_t mb, const int t0, const int L) {
    const int lane = fresh_lane(), wave = F.wave, tid = wave * 64 + lane;
    const float wscale = 0.25f * 0.08838834764831845f;
        bf16x8 afr[2][8]; float wq[2][16];
#pragma unroll
        for (int rt = 0; rt < 2; ++rt) {
            const int r = lane & 31, q = (r >> 2) & 1, head = 4 * (r >> 3) + (r & 3);
            const bf16* src = iq + (mb + t0 + 4 * wave + 2 * rt + q) * DM + head * IDIM + 8 * (lane >> 5);
#pragma unroll
            for (int ks = 0; ks < 8; ++ks) afr[rt][ks] = *(const bf16x8*)(src + ks * 16);
            const float* wsrc = misc + (mb + t0 + 4 * wave + 2 * rt + (lane >> 5)) * 256 + 128;
#pragma unroll
            for (int i4 = 0; i4 < 4; ++i4) { const f32x4 w4 = *(const f32x4*)(wsrc + 4 * i4); wq[rt][4 * i4 + 0] = w4.x * wscale; wq[rt][4 * i4 + 1] = w4.y * wscale; wq[rt][4 * i4 + 2] = w4.z * wscale; wq[rt][4 * i4 + 3] = w4.w * wscale; }
        }
        const int nkt = L / 64;
        u32x4 st[2];
#define IDX_LOADK(KT) do { _Pragma("unroll") for (int i = 0; i < 2; ++i) { const int e = tid + 512 * i, key = e >> 4, ch = e & 15; st[i] = *(const u32x4*)(kidx + (mb + (KT) * 64 + key) * IDIM + ch * 8); } } while (0)
#define IDX_STOREK(BI) do { _Pragma("unroll") for (int i = 0; i < 2; ++i) { const int e = tid + 512 * i, key = e >> 4, ch = e & 15; *(LAS u32x4*)(F.lds + (BI) * IDX_KBUF + key * IDX_KROW + ch * 16) = st[i]; } } while (0)
        IDX_LOADK(0); IDX_STOREK(0);
        if (nkt > 1) { IDX_LOADK(1); IDX_STOREK(1); }
        __syncthreads();
        bf16x8 bf0[8], bf1[8];
#pragma unroll
        for (int ks = 0; ks < 8; ++ks) bf0[ks] = *(const LAS bf16x8*)(F.lds + (lane & 31) * IDX_KROW + (ks * 16 + 8 * (lane >> 5)) * 2);
        f32x16 accA, accB;
#pragma unroll
        for (int i = 0; i < 16; ++i) accB[i] = 0.f;
        float sprev[2] = {0.f, 0.f};
        unsigned* srow = (unsigned*)scr + (size_t)(4 * wave + (lane >> 5)) * (SEQ / 2) + (lane & 31);
        int cur = 0;
#define IDX_MMA(ACC, RT, BF) do { _Pragma("unroll") for (int i = 0; i < 16; ++i) ACC[i] = 0.f; \
        if (VAR & 16) { asm volatile("" : "+v"(ACC) : "v"(BF[0]), "v"(BF[7])); } else { _Pragma("unroll") for (int ks = 0; ks < 8; ++ks) ACC = __builtin_amdgcn_mfma_f32_32x32x16_bf16(afr[RT][ks], BF[ks], ACC, 0, 0, 0); } } while (0)
#define IDX_EPI(ACC, RT, SUB, SR, DO) do { if (VAR & 2) { asm volatile("" :: "v"(ACC)); break; } float s_ = 0.f; _Pragma("unroll") for (int i = 0; i < 16; ++i) { const float af_ = ACC[i]; const int ai_ = __builtin_bit_cast(int, af_); s_ += wq[RT][i] * __builtin_bit_cast(float, ai_ > 0 ? ai_ : 0); } \
        if ((SUB) == 0) sprev[RT] = s_; else { const f16 lo_ = (f16)sprev[RT], hi_ = (f16)s_; const unsigned pk_ = (unsigned)__builtin_bit_cast(unsigned short, lo_) | ((unsigned)__builtin_bit_cast(unsigned short, hi_) << 16); \
            if (VAR & 1) asm volatile("" :: "v"(pk_)); else if (DO) (SR)[(size_t)(2 * (RT)) * (SEQ / 2)] = pk_; } } while (0)
#define IDX_ILV() do { _Pragma("unroll") for (int k_ = 0; k_ < 8; ++k_) { __builtin_amdgcn_sched_group_barrier(0x008, 1, 0); __builtin_amdgcn_sched_group_barrier(0x002, 5, 0); } } while (0)
        for (int kt = 0; kt < nkt; ++kt) {
            const int nxt = cur == 2 ? 0 : cur + 1, nx2 = nxt == 2 ? 0 : nxt + 1;
            if (!(VAR & 4)) { const int ktl = kt + 2 < nkt ? kt + 2 : nkt - 1; IDX_LOADK(ktl); __builtin_amdgcn_sched_barrier(0); }
            LAS unsigned char* buf = F.lds + cur * IDX_KBUF;
#pragma unroll
            for (int ks = 0; ks < 8; ++ks) bf1[ks] = *(const LAS bf16x8*)(buf + (32 + (lane & 31)) * IDX_KROW + (ks * 16 + 8 * (lane >> 5)) * 2);
            unsigned* srp = kt > 0 ? srow - 32 : srow;
            IDX_MMA(accA, 0, bf0); IDX_EPI(accB, 1, 1, srp, true); IDX_ILV();
            IDX_MMA(accB, 1, bf0); IDX_EPI(accA, 0, 0, srow, true); IDX_ILV();
            {   LAS unsigned char* nb = F.lds + nxt * IDX_KBUF;
#pragma unroll
                for (int ks = 0; ks < 8; ++ks) bf0[ks] = *(const LAS bf16x8*)(nb + (lane & 31) * IDX_KROW + (ks * 16 + 8 * (lane >> 5)) * 2);
            }
            IDX_MMA(accA, 0, bf1); IDX_EPI(accB, 1, 0, srow, true); IDX_ILV();
            IDX_MMA(accB, 1, bf1); IDX_EPI(accA, 0, 1, srow, true); IDX_ILV();
            __builtin_amdgcn_sched_barrier(0);
            if (!(VAR & 4)) IDX_STOREK(nx2);
            if (!(VAR & 8)) __syncthreads();
            srow += 32; cur = nxt;
        }
        IDX_EPI(accB, 1, 1, srow - 32, true);
#undef IDX_MMA
#undef IDX_EPI
#undef IDX_ILV
#undef IDX_LOADK
#undef IDX_STOREK
}
template <int NSEL> __device__ __forceinline__ void p3_indexer(const Params& p, const Frame& F) {
    const int lane = F.lane, wave = F.wave, tid = F.tid;
    const bf16* iq = (const bf16*)(p.ws + WS_IQ); const bf16* kidx = (const bf16*)(p.ws + WS_KIDX); const float* misc = (const float*)(p.ws + WS_MISC);
    u16* idxo = (u16*)(p.ws + WS_IDX);
    f16* scr = (f16*)(p.ws + WS_SCR) + (size_t)F.bid * 32 * SEQ;
    const float wscale = 0.25f * 0.08838834764831845f;
    for (int uu = F.bid; uu < 512; uu += F.G) {
        const int b = uu & 1; int hc = (uu & 255) >> 1; if (uu >> 8) hc = 255 - hc;
        const int c = hc >> 1, L = (c + 1) * CHUNK, t0 = hc * 32; const size_t mb = (size_t)b * SEQ;
        if (L <= TOPK) {
#pragma unroll
            for (int q = 0; q < 4; ++q) { u16* o = idxo + (mb + t0 + 4 * wave + q) * TOPK;
#pragma unroll
                for (int j = 0; j < 4; ++j) { const int i = lane + 64 * j; o[i] = (u16)(i < L ? i : 0); } }
            continue;
        }
        IDX_SCORE_EXTRA();
        { TPR_BEGIN(1); idx_score_unit<0>(F, iq, kidx, misc, scr, mb, t0, L); TPR_END(1); }
        VM_WAIT();
        __builtin_amdgcn_fence(__ATOMIC_ACQUIRE, "agent");
        VM_WAIT();
        { TPR_BEGIN(2);
#pragma unroll 1
        for (int q = 0; q < 4 * NSEL; ++q)
            idx_select_query((const unsigned*)(scr + (size_t)(4 * wave + (q & 3)) * SEQ), L, idxo + (mb + t0 + 4 * wave + (q & 3)) * TOPK, lane, F.lds + IDX_STG_OFF + wave * IDX_STG_W);
        VM_WAIT();
        TPR_END(2); }
    }
}

__device__ __forceinline__ void p3_score_both(const Params& p, const Frame& F) {
    const bf16* iq = (const bf16*)(p.ws + WS_IQ); const bf16* kidx = (const bf16*)(p.ws + WS_KIDX); const float* misc = (const float*)(p.ws + WS_MISC);
    f16* scr2 = (f16*)(p.ws + WS_S4) + (size_t)F.bid * 64 * SEQ;
#pragma unroll 1
    for (int k = 0; k < 2; ++k) { const int uu = F.bid + k * F.G; if (uu >= 512) break;
        const int b = uu & 1; int hc = (uu & 255) >> 1; if (uu >> 8) hc = 255 - hc;
        const int c = hc >> 1, L = (c + 1) * CHUNK, t0 = hc * 32; const size_t mb = (size_t)b * SEQ;
        if (L <= TOPK) continue;
        idx_score_unit<0>(F, iq, kidx, misc, scr2 + (size_t)k * 32 * SEQ, mb, t0, L);
    }
}

constexpr int DSA_ROW = 544, DSA_WBUF = 16 * DSA_ROW, DSA_WREG = 2 * DSA_WBUF;
constexpr int DSA_IDX_OFF = 8 * DSA_WREG, DSA_BKT_OFF = DSA_IDX_OFF + 8 * 512, DSA_BIAS_OFF = DSA_BKT_OFF + 8 * 256;
static_assert(DSA_BIAS_OFF + 2048 <= MISC_OFF, "dsa lds");
__device__ __forceinline__ unsigned t5_bucket(int rel) {
    const unsigned ret = rel > 0 ? 16u : 0u; const int n = rel < 0 ? -rel : rel; unsigned v;
    if (n < 8) v = (unsigned)n; else { const unsigned n2 = (unsigned)n * (unsigned)n; v = 2u + (31u - (unsigned)__clz((int)n2)); if (v > 15u) v = 15u; }
    return ret + v;
}
constexpr int DSA_STG_OFF = DSA_BIAS_OFF + 2048;
static_assert(DSA_STG_OFF + 8 * 1024 <= MISC_OFF, "dsa lds 2");
template <bool FUSED> __device__ __forceinline__ void p4_dsa(const Params& p, const Frame& F) {
    const int lane = F.lane, wave = F.wave, g = lane >> 4, l15 = lane & 15;
    const u16* idx = (const u16*)(p.ws + WS_IDX); const bf16* clat = (const bf16*)(p.ws + WS_CLAT);
    const bf16* qlat = (const bf16*)p.out; bf16* olat = (bf16*)p.out;
    LAS float* biasT = (LAS float*)(F.lds + DSA_BIAS_OFF);
    biasT[F.tid] = KARG_IN(I_RELB)[F.tid];
    __syncthreads();
    LAS unsigned char* wb = F.lds + wave * DSA_WREG;
    LAS unsigned char* stg2 = F.lds + DSA_STG_OFF + wave * 1024;
    LAS u16* widx = FUSED ? (LAS u16*)(stg2 + 128) : (LAS u16*)(F.lds + DSA_IDX_OFF + wave * 512);
    LAS unsigned* wbkt = (LAS unsigned*)(F.lds + DSA_BKT_OFF + wave * 256);
    const f16* scr2 = (const f16*)(p.ws + WS_S4) + (size_t)F.bid * 64 * SEQ;
    const float SC = 0.08838834764831845f;
#pragma unroll 1
    for (int uq = 0; uq < 8; ++uq) {
        const int uu = F.bid + (uq >> 2) * F.G, qq = uq & 3; if (uu >= 512) break;
        if (FUSED) { if ((uq + (wave >> 2)) & 1) __builtin_amdgcn_s_setprio(1); else __builtin_amdgcn_s_setprio(0); }
        const int ub = uu & 1; int uhc = (uu & 255) >> 1; if (uu >> 8) uhc = 255 - uhc;
        const int mq = ub * SEQ + uhc * 32 + 4 * wave + qq;
        const int tpos = mq & (SEQ - 1), b = mq >> 13, c = tpos >> 6;
        const int n = ((c + 1) * CHUNK < TOPK) ? (c + 1) * CHUNK : TOPK, ntile = n >> 4;
        bf16x8 bq[8];
        { const bf16* qs = qlat + (size_t)mq * 4096 + l15 * 256 + 8 * g;
#pragma unroll
          for (int kk = 0; kk < 8; ++kk) bq[kk] = *(const bf16x8*)(qs + 32 * kk); }
        __builtin_amdgcn_sched_barrier(0);
        u32x2 iv;
        if (FUSED) {
            const int LU = (c + 1) * CHUNK;
            if (LU <= TOPK) {
#pragma unroll
                for (int j = 0; j < 4; ++j) { const int i = lane + 64 * j; widx[i] = (u16)(i < LU ? i : 0); }
            } else idx_select_query((const unsigned*)(scr2 + (size_t)((uq >> 2) * 32 + 4 * wave + qq) * SEQ), LU, nullptr, lane, stg2);
            LDS_WAIT();
            iv = *(const LAS u32x2*)(widx + 4 * lane);
        } else {
            iv = *(const u32x2*)(idx + (size_t)mq * TOPK + 4 * lane);
            *(LAS u32x2*)(widx + 4 * lane) = iv;
        }
        wbkt[lane] = t5_bucket((int)(iv.x & 0xffffu) - tpos) | (t5_bucket((int)(iv.x >> 16) - tpos) << 8) | (t5_bucket((int)(iv.y & 0xffffu) - tpos) << 16) | (t5_bucket((int)(iv.y >> 16) - tpos) << 24);
        LDS_WAIT();
        const bf16* cb = clat + (size_t)b * SEQ * DLAT + (lane & 31) * 8;
        u32x4 grA[8], grB[8];
#define DSA_GATHER(T_, GR_) do { _Pragma("unroll") for (int i = 0; i < 8; ++i) { const unsigned key = widx[16 * (T_) + 2 * i + (lane >> 5)]; GR_[i] = *(const u32x4*)(cb + (size_t)key * DLAT); } } while (0)
#define DSA_PUT(BUF_, GR_) do { _Pragma("unroll") for (int i = 0; i < 8; ++i) *(LAS u32x4*)((BUF_) + (2 * i + (lane >> 5)) * DSA_ROW + (lane & 31) * 16) = GR_[i]; } while (0)
#define DSA_QKA(BUFA_) do { LAS unsigned char* bufa = (BUFA_); sa_ = (f32x4){0.f, 0.f, 0.f, 0.f}; \
            _Pragma("unroll") for (int kk = 0; kk < 8; ++kk) { const bf16x8 a = *(const LAS bf16x8*)(bufa + l15 * DSA_ROW + (32 * kk + 8 * g) * 2); sa_ = __builtin_amdgcn_mfma_f32_16x16x32_bf16(a, bq[kk], sa_, 0, 0, 0); } } while (0)
#define DSA_PAIR(T_, BUFA_, BUFB_) do { LAS unsigned char* bufa = (BUFA_); LAS unsigned char* bufb = (BUFB_); \
            f32x4 sb_ = (f32x4){0.f, 0.f, 0.f, 0.f}; \
            _Pragma("unroll") for (int kk = 0; kk < 8; ++kk) { const bf16x8 a = *(const LAS bf16x8*)(bufb + l15 * DSA_ROW + (32 * kk + 8 * g) * 2); sb_ = __builtin_amdgcn_mfma_f32_16x16x32_bf16(a, bq[kk], sb_, 0, 0, 0); } \
            const unsigned bka = wbkt[4 * (T_) + g], bkb = wbkt[4 * (T_) + 4 + g]; \
            float x[8]; \
            _Pragma("unroll") for (int r = 0; r < 4; ++r) { x[r] = sa_[r] * SC + biasT[((bka >> (8 * r)) & 0xffu) * 16 + l15]; x[4 + r] = sb_[r] * SC + biasT[((bkb >> (8 * r)) & 0xffu) * 16 + l15]; } \
            float tm = fmaxf(fmaxf(fmaxf(x[0], x[1]), fmaxf(x[2], x[3])), fmaxf(fmaxf(x[4], x[5]), fmaxf(x[6], x[7]))); \
            tm = x16_max(tm); tm = x32_max(tm); \
            if (__any(tm > mrun)) { const float mn = fmaxf(mrun, tm), al = __expf(mrun - mn); \
                _Pragma("unroll") for (int mt = 0; mt < 16; ++mt) O[mt] = O[mt] * al; \
                lsum *= al; mrun = mn; } \
            float pr[8]; \
            _Pragma("unroll") for (int r = 0; r < 8; ++r) { pr[r] = __expf(x[r] - mrun); lsum += pr[r]; } \
            u32x4 pw; pw.x = cvt_pk_bf16(pr[0], pr[1]); pw.y = cvt_pk_bf16(pr[2], pr[3]); pw.z = cvt_pk_bf16(pr[4], pr[5]); pw.w = cvt_pk_bf16(pr[6], pr[7]); \
            const bf16x8 pf = __builtin_bit_cast(bf16x8, pw); \
            const LAS unsigned char* tra = bufa + (4 * g + (l15 >> 2)) * DSA_ROW + (4 * (lane & 3)) * 2; \
            const LAS unsigned char* trb = bufb + (4 * g + (l15 >> 2)) * DSA_ROW + (4 * (lane & 3)) * 2; \
            _Pragma("unroll") for (int mt = 0; mt < 16; ++mt) { \
                const v4i16_t ta = __builtin_amdgcn_ds_read_tr16_b64_v4i16((LAS v4i16_t*)(tra + mt * 32)), tb = __builtin_amdgcn_ds_read_tr16_b64_v4i16((LAS v4i16_t*)(trb + mt * 32)); \
                u32x4 av; { const u32x2 ua = __builtin_bit_cast(u32x2, ta), ub_ = __builtin_bit_cast(u32x2, tb); av.x = ua.x; av.y = ua.y; av.z = ub_.x; av.w = ub_.y; } \
                O[mt] = __builtin_amdgcn_mfma_f32_16x16x32_bf16(__builtin_bit_cast(bf16x8, av), pf, O[mt], 0, 0, 0); } } while (0)
        DSA_GATHER(0, grA);
        DSA_GATHER(1, grB);
        DSA_PUT(wb, grA);
        f32x4 O[16];
#pragma unroll
        for (int mt = 0; mt < 16; ++mt) O[mt] = (f32x4){0.f, 0.f, 0.f, 0.f};
        float mrun = -INFINITY, lsum = 0.f;
        for (int T = 0; T < ntile; T += 2) {
            f32x4 sa_;
            if (T + 2 < ntile) DSA_GATHER(T + 2, grA);
            asm volatile("" ::: "memory");
            DSA_QKA(wb);
            asm volatile("" ::: "memory");
            DSA_PUT(wb + DSA_WBUF, grB);
            if (T + 3 < ntile) DSA_GATHER(T + 3, grB);
            asm volatile("" ::: "memory");
            DSA_PAIR(T, wb, wb + DSA_WBUF);
            asm volatile("" ::: "memory");
            if (T + 2 < ntile) DSA_PUT(wb, grA);
        }
#undef DSA_QKA
#undef DSA_GATHER
#undef DSA_PUT
#undef DSA_PAIR
        lsum = x16_sum(lsum); lsum = x32_sum(lsum);
        const float inv = __frcp_rn(lsum);
        bf16* od = olat + (size_t)mq * 4096 + l15 * 256 + 4 * g;
#pragma unroll
        for (int mt = 0; mt < 16; ++mt) { u32x2 w; w.x = cvt_pk_bf16(O[mt][0] * inv, O[mt][1] * inv); w.y = cvt_pk_bf16(O[mt][2] * inv, O[mt][3] * inv); *(u32x2*)(od + 16 * mt) = w; }
        LDS_WAIT();
    }    if (FUSED) __builtin_amdgcn_s_setprio(0);
}

constexpr int G1_ROW = 528, G1_ARR = 64 * G1_ROW, G1_GA = 4 * G1_ARR, G1_TOT = G1_GA + 4096, G1_VROW = 1040;
static_assert(G1_TOT + 2048 <= MISC_OFF && 64 * G1_VROW <= G1_GA, "g1 lds");
__device__ __forceinline__ void p6_gla1(const Params& p, const Frame& F) {
    const int tid = F.tid, lane = F.lane, wave = F.wave, g = lane >> 4, l15 = lane & 15;
    const bf16* gqk = (const bf16*)(p.ws + WS_IQ); const bf16* gv = (const bf16*)(p.ws + WS_DQ); const float* misc = (const float*)(p.ws + WS_MISC);
    bf16* qfp = (bf16*)(p.ws + WS_QFP); bf16* kdt = (bf16*)(p.ws + WS_KDT); bf16* sc = (bf16*)(p.ws + WS_SC); bf16* vt = (bf16*)(p.ws + WS_GVT); float* dec = (float*)(p.ws + WS_DCRAW);
    LAS unsigned char* lds = F.lds;
    LAS float* GA = (LAS float*)(lds + G1_GA); LAS float* TOT = (LAS float*)(lds + G1_TOT);
#define G1_FETCH(UU_) do { const int b_ = (UU_) >> 9, h_ = ((UU_) >> 7) & 3, c_ = (UU_) & 127; const size_t m0_ = (size_t)b_ * SEQ + c_ * CHUNK; \
        if (lane < 32) { _Pragma("unroll") for (int r_ = 0; r_ < 8; ++r_) { const int t_ = 8 * wave + r_; const bf16* s_ = gqk + (m0_ + t_) * DM + h_ * GDK + lane * 8; \
            __builtin_amdgcn_global_load_lds((const unsigned*)s_, (LAS unsigned*)(lds + 2 * G1_ARR + t_ * G1_ROW), 16, 0, 0); \
            __builtin_amdgcn_global_load_lds((const unsigned*)(s_ + 1024), (LAS unsigned*)(lds + 3 * G1_ARR + t_ * G1_ROW), 16, 0, 0); } } \
        if (wave < 4) { const int i_ = wave * 64 + lane; __builtin_amdgcn_global_load_lds((const unsigned*)(misc + (m0_ + (i_ >> 2)) * 256 + 144 + 4 * (i_ & 3)), (LAS unsigned*)(lds + G1_GA + wave * 1024), 16, 0, 0); } } while (0)
    if (F.bid < 1024) G1_FETCH(F.bid);
    for (int uu = F.bid; uu < 1024; uu += F.G) {
        const int b = uu >> 9, h = (uu >> 7) & 3, c = uu & 127; const size_t m0 = (size_t)b * SEQ + c * CHUNK;
        const int half = tid >> 8, d = tid & 255;
        float w2[16];
#pragma unroll
        for (int j = 0; j < 16; ++j) w2[j] = KARG_IN(I_WA2)[j * 1024 + h * 256 + d];
        const float ba = KARG_IN(I_BA)[h * 256 + d];
        VM_WAIT();
        __syncthreads();
        u32x4 vr[8];
#pragma unroll
        for (int i = 0; i < 8; ++i) { const int e = tid + 512 * i, t = e >> 6, ch = e & 63; vr[i] = *(const u32x4*)(gv + (m0 + t) * DM + h * GDV + ch * 8); }
        __builtin_amdgcn_sched_barrier(0);
        float la[32]; float run = 0.f;
#pragma unroll
        for (int i = 0; i < 32; ++i) {
            const LAS f32x4* ga4 = (const LAS f32x4*)(GA + (32 * half + i) * 16);
            float x = ba;
#pragma unroll
            for (int j4 = 0; j4 < 4; ++j4) { const f32x4 a = ga4[j4]; x += a.x * w2[4 * j4] + a.y * w2[4 * j4 + 1] + a.z * w2[4 * j4 + 2] + a.w * w2[4 * j4 + 3]; }
            const float ls = fminf(x, 0.f) - __logf(1.0f + __expf(-fabsf(x)));
            run += ls * 0.0625f; la[i] = run;
        }
        TOT[half * 256 + d] = run;
        __syncthreads();
        u32x4 qn[4], kn[4]; f32x2 gn = (f32x2){0.f, 0.f};
        const int un = uu + F.G; const bool hasn = un < 1024;
        if (hasn) { const int bn = un >> 9, hn = (un >> 7) & 3, cn = un & 127; const size_t mn = (size_t)bn * SEQ + cn * CHUNK;
#pragma unroll
            for (int i = 0; i < 4; ++i) { const int e = tid + 512 * i, t = e >> 5, ch = e & 31; const bf16* s_ = gqk + (mn + t) * DM + hn * GDK + ch * 8; qn[i] = *(const u32x4*)s_; kn[i] = *(const u32x4*)(s_ + 1024); }
            { const int e = tid * 2, t = e >> 4, j = e & 15; gn = *(const f32x2*)(misc + (mn + t) * 256 + 144 + j); } }
        __builtin_amdgcn_sched_barrier(0);
        const float off = half ? TOT[d] : 0.f, blast = TOT[d] + TOT[256 + d];
        unsigned kdp[16];
#pragma unroll
        for (int i = 0; i < 32; ++i) {
            const int t = 32 * half + i; const float bc = off + la[i];
            const float eb = __expf(bc), ebi = __expf(-bc);
            const float q = bf2f(*(const LAS bf16*)(lds + 2 * G1_ARR + t * G1_ROW + d * 2)) * 0.0625f, k = bf2f(*(const LAS bf16*)(lds + 3 * G1_ARR + t * G1_ROW + d * 2));
            const unsigned qq = cvt_pk_bf16(q * eb, q * ebi), kk = cvt_pk_bf16(k * eb, k * ebi);
            *(LAS bf16*)(lds + 0 * G1_ARR + t * G1_ROW + d * 2) = (bf16)(qq & 0xffffu);
            *(LAS bf16*)(lds + 2 * G1_ARR + t * G1_ROW + d * 2) = (bf16)(qq >> 16);
            *(LAS bf16*)(lds + 3 * G1_ARR + t * G1_ROW + d * 2) = (bf16)(kk & 0xffffu);
            *(LAS bf16*)(lds + 1 * G1_ARR + t * G1_ROW + d * 2) = (bf16)(kk >> 16);
            const float kd = k * __expf(blast - bc);
            if (i & 1) kdp[i >> 1] = cvt_pk_bf16(__uint_as_float(kdp[i >> 1]), kd); else kdp[i >> 1] = __float_as_uint(kd);
        }
        { bf16* kb = kdt + (((size_t)uu * 16 + (d >> 4)) * 2 + half) * 512 + (d & 15) * 8;
#pragma unroll
          for (int j = 0; j < 4; ++j) *(u32x4*)(kb + j * 128) = (u32x4){kdp[4 * j], kdp[4 * j + 1], kdp[4 * j + 2], kdp[4 * j + 3]}; }
        if (half == 0) dec[(size_t)uu * 256 + d] = __expf(blast);
        LDS_WAIT(); asm volatile("" ::: "memory"); __builtin_amdgcn_s_barrier(); asm volatile("" ::: "memory");
        {
#pragma unroll
            for (int bi = 0; bi < 4; ++bi) { const int blk = wave * 4 + bi, tt = blk >> 3, kk = blk & 7;
                const LAS unsigned char* rp = lds + 0 * G1_ARR + (16 * tt + l15) * G1_ROW + (32 * kk + 4 * g) * 2;
                const u32x2 p1 = *(const LAS u32x2*)rp, p2 = *(const LAS u32x2*)(rp + 32);
                *(u32x4*)(qfp + (((size_t)uu * 4 + tt) * 8 + kk) * 512 + lane * 8) = (u32x4){p1.x, p1.y, p2.x, p2.y}; }
        }
        {
            const int tm = wave >> 1, tn0 = (wave & 1) * 2;
            f32x4 lo[2], up[2];
#pragma unroll
            for (int j = 0; j < 2; ++j) { lo[j] = (f32x4){0.f, 0.f, 0.f, 0.f}; up[j] = (f32x4){0.f, 0.f, 0.f, 0.f}; }
#pragma unroll
            for (int ks = 0; ks < 8; ++ks) {
                const int ao = (16 * tm + l15) * G1_ROW + (32 * ks + 8 * g) * 2;
                const bf16x8 aF = *(const LAS bf16x8*)(lds + 0 * G1_ARR + ao), aB = *(const LAS bf16x8*)(lds + 2 * G1_ARR + ao);
#pragma unroll
                for (int j = 0; j < 2; ++j) {
                    const int bo = (16 * (tn0 + j) + l15) * G1_ROW + (32 * ks + 8 * g) * 2;
                    const bf16x8 bB = *(const LAS bf16x8*)(lds + 1 * G1_ARR + bo), bF = *(const LAS bf16x8*)(lds + 3 * G1_ARR + bo);
                    lo[j] = __builtin_amdgcn_mfma_f32_16x16x32_bf16(aF, bB, lo[j], 0, 0, 0);
                    up[j] = __builtin_amdgcn_mfma_f32_16x16x32_bf16(aB, bF, up[j], 0, 0, 0);
                }
            }
#pragma unroll
            for (int j = 0; j < 2; ++j) { const int s = 16 * (tn0 + j) + l15;
#pragma unroll
                for (int r = 0; r < 4; ++r) { const int t = 16 * tm + 4 * g + r; const float v = (s <= t) ? lo[j][r] : up[j][r];
                    sc[(((size_t)uu * 4 + tm) * 2 + (s >> 5)) * 512 + ((((s >> 3) & 3) * 16 + (t & 15)) * 8) + (s & 7)] = (bf16)(cvt_pk_bf16(v, 0.f) & 0xffffu); } }
        }
        __syncthreads();
        if (hasn) {
#pragma unroll
            for (int i = 0; i < 4; ++i) { const int e = tid + 512 * i, t = e >> 5, ch = e & 31; *(LAS u32x4*)(lds + 2 * G1_ARR + t * G1_ROW + ch * 16) = qn[i]; *(LAS u32x4*)(lds + 3 * G1_ARR + t * G1_ROW + ch * 16) = kn[i]; }
            { const int e = tid * 2, t = e >> 4, j = e & 15; *(LAS f32x2*)(GA + t * 16 + j) = gn; } }
#pragma unroll
        for (int i = 0; i < 8; ++i) { const int e = tid + 512 * i, t = e >> 6, ch = e & 63; *(LAS u32x4*)(lds + t * G1_VROW + ch * 16) = vr[i]; }
        LDS_WAIT(); asm volatile("" ::: "memory"); __builtin_amdgcn_s_barrier(); asm volatile("" ::: "memory");
        { unsigned vp[32];
#pragma unroll
          for (int i = 0; i < 32; ++i) { const unsigned a = *(const LAS bf16*)(lds + (2 * i) * G1_VROW + tid * 2), bb = *(const LAS bf16*)(lds + (2 * i + 1) * G1_VROW + tid * 2); vp[i] = a | (bb << 16); }
          bf16* vb = vt + (((size_t)uu * 32 + (tid >> 4)) * 2) * 512 + (tid & 15) * 8;
#pragma unroll
          for (int j = 0; j < 8; ++j) *(u32x4*)(vb + (j >> 2) * 512 + (j & 3) * 128) = (u32x4){vp[4 * j], vp[4 * j + 1], vp[4 * j + 2], vp[4 * j + 3]}; }
    }
#undef G1_FETCH
    __syncthreads();
}

constexpr int G2_GRP = 16;
constexpr int G2A_SLOT = 49152;
static_assert(3 * G2A_SLOT <= MISC_OFF, "pass A lds");
__device__ __forceinline__ void gla_scan_state(const Params& p, const Frame& F) {
    const int lane = F.lane, wave = F.wave, g = lane >> 4;
    const bf16* kdt = (const bf16*)(p.ws + WS_KDT); const bf16* vt = (const bf16*)(p.ws + WS_GVT); const float* dec = (const float*)(p.ws + WS_DCRAW);
    unsigned* sloc = (unsigned*)(p.ws + WS_S3);
    LAS unsigned char* lds = F.lds;
    const int d0 = 4 * (wave & 3), n0 = 4 * (wave >> 2);
#define G2A_COPY(gsrc_, ldsoff_, nblk_) do { unsigned l16_ = (unsigned)lane * 16u; asm volatile("" : "+v"(l16_)); \
        _Pragma("unroll") for (int q_ = 0; q_ < (nblk_); ++q_) \
        __builtin_amdgcn_global_load_lds((const unsigned*)(((const char*)(gsrc_) + (size_t)(wave * (nblk_) + q_) * 1024) + l16_), (LAS unsigned*)(lds + (ldsoff_) + (wave * (nblk_) + q_) * 1024), 16, 0, 0); } while (0)
#define G2A_ISSUE(cc_, slot_) do { const size_t u1_ = ubase + (cc_); const int so_ = (slot_) * G2A_SLOT; G2A_COPY(kdt + u1_ * 16384, so_, 4); G2A_COPY(vt + (u1_ * 32 + vq * 8) * 1024, so_ + 32768, 2); } while (0)
    for (int uu = F.bid; uu < 256; uu += F.G) {
        const int bh = uu & 7, vq = (uu >> 3) & 3, grp = uu >> 5;
        const size_t ubase = (size_t)bh * 128 + grp * G2_GRP;
        __syncthreads();
        G2A_ISSUE(0, 0); G2A_ISSUE(1, 1);
        f32x4 sa[4][4];
#pragma unroll
        for (int i = 0; i < 4; ++i)
#pragma unroll
            for (int nt = 0; nt < 4; ++nt) sa[i][nt] = (f32x4){0.f, 0.f, 0.f, 0.f};
        int slot = 0;
#pragma unroll 1
        for (int cc = 0; cc < G2_GRP; ++cc) {
            if (cc + 1 < G2_GRP) asm volatile("s_waitcnt vmcnt(6)" ::: "memory"); else asm volatile("s_waitcnt vmcnt(0)" ::: "memory");
            asm volatile("s_waitcnt lgkmcnt(0)" ::: "memory"); __builtin_amdgcn_s_barrier(); asm volatile("" ::: "memory");
            f32x4 DC[4];
            { const float* dcu = dec + (ubase + cc) * 256 + 16 * d0;
#pragma unroll
              for (int i = 0; i < 4; ++i) DC[i] = *(const f32x4*)(dcu + (4 * g + 16 * i)); }
            __builtin_amdgcn_sched_barrier(0);
            const int s2 = slot == 0 ? 2 : slot - 1;
            if (cc + 2 < G2_GRP) G2A_ISSUE(cc + 2, s2);
            __builtin_amdgcn_sched_barrier(0);
            const LAS unsigned char* sb = lds + slot * G2A_SLOT;
            bf16x8 VT[4][2], KD[4][2];
#pragma unroll
            for (int nt = 0; nt < 4; ++nt)
#pragma unroll
                for (int kk = 0; kk < 2; ++kk) VT[nt][kk] = *(const LAS bf16x8*)(sb + 32768 + ((n0 + nt) * 2 + kk) * 1024 + lane * 16);
#pragma unroll
            for (int i = 0; i < 4; ++i)
#pragma unroll
                for (int kk = 0; kk < 2; ++kk) KD[i][kk] = *(const LAS bf16x8*)(sb + ((d0 + i) * 2 + kk) * 1024 + lane * 16);
#pragma unroll
            for (int i = 0; i < 4; ++i)
#pragma unroll
                for (int nt = 0; nt < 4; ++nt) { sa[i][nt] = sa[i][nt] * DC[i];
                    sa[i][nt] = __builtin_amdgcn_mfma_f32_16x16x32_bf16(KD[i][0], VT[nt][0], sa[i][nt], 0, 0, 0);
                    sa[i][nt] = __builtin_amdgcn_mfma_f32_16x16x32_bf16(KD[i][1], VT[nt][1], sa[i][nt], 0, 0, 0); }
            slot = slot == 2 ? 0 : slot + 1;
        }
        u32x4* ub = (u32x4*)sloc + (size_t)uu * 4096;
#pragma unroll
        for (int i = 0; i < 4; ++i)
#pragma unroll
            for (int hh = 0; hh < 2; ++hh) { u32x4 w; w.x = cvt_pk_bf16(sa[i][2 * hh][0], sa[i][2 * hh][1]); w.y = cvt_pk_bf16(sa[i][2 * hh][2], sa[i][2 * hh][3]); w.z = cvt_pk_bf16(sa[i][2 * hh + 1][0], sa[i][2 * hh + 1][1]); w.w = cvt_pk_bf16(sa[i][2 * hh + 1][2], sa[i][2 * hh + 1][3]);
                (ub + (((d0 + i) * 2 + (n0 >> 2)) * 2 + hh) * 64)[(unsigned)lane] = w; }
    }
#undef G2A_COPY
#undef G2A_ISSUE
    __syncthreads();
}
constexpr int G2L_SB = 0, G2L_QF = 65536, G2L_KD = 98304, G2L_VT = 131072, G2L_SC = 147456;
static_assert(G2L_SC + 8192 <= MISC_OFF, "scan lds");
__device__ __forceinline__ void gla_scan_full(const Params& p, const Frame& F, bf16* oraw) {
    const int lane = F.lane, wave = F.wave, g = lane >> 4, l15 = lane & 15;
    const bf16* qfp = (const bf16*)(p.ws + WS_QFP); const bf16* kdt = (const bf16*)(p.ws + WS_KDT); const bf16* sc = (const bf16*)(p.ws + WS_SC); const bf16* vt = (const bf16*)(p.ws + WS_GVT); const float* dec = (const float*)(p.ws + WS_DCRAW);
    const unsigned* sloc = (const unsigned*)(p.ws + WS_S3);
    LAS unsigned char* lds = F.lds;
    const int tw = wave & 3, d0 = 4 * (wave & 3), n0 = 4 * (wave >> 2);
#define G2D_COPY(gsrc_, ldsoff_, nblk_) do { _Pragma("unroll") for (int b_ = 0; b_ < (nblk_); ++b_) \
        __builtin_amdgcn_global_load_lds((const unsigned*)((const char*)(gsrc_) + (size_t)(wave * (nblk_) + b_) * 1024 + lane * 16), (LAS unsigned*)(lds + (ldsoff_) + (wave * (nblk_) + b_) * 1024), 16, 0, 0); } while (0)
#define G2D_ISSUE_QF(cc_) do { const size_t u1_ = ubase + (cc_); G2D_COPY(qfp + u1_ * 16384, G2L_QF, 4); } while (0)
#define G2D_ISSUE_VKS(cc_) do { const size_t u1_ = ubase + (cc_); G2D_COPY(vt + (u1_ * 32 + vq * 8) * 1024, G2L_VT, 2); G2D_COPY(kdt + u1_ * 16384, G2L_KD, 4); G2D_COPY(sc + u1_ * 4096, G2L_SC, 1); } while (0)
#define G2D_PUBLISH() do { _Pragma("unroll") for (int nt = 0; nt < 4; ++nt) { _Pragma("unroll") for (int j = 0; j < 2; ++j) { u32x4 w; \
        w.x = cvt_pk_bf16(sa[2 * j][nt][0], sa[2 * j][nt][1]); w.y = cvt_pk_bf16(sa[2 * j][nt][2], sa[2 * j][nt][3]); w.z = cvt_pk_bf16(sa[2 * j + 1][nt][0], sa[2 * j + 1][nt][1]); w.w = cvt_pk_bf16(sa[2 * j + 1][nt][2], sa[2 * j + 1][nt][3]); \
        *(LAS u32x4*)(lds + G2L_SB + ((n0 + nt) * 8 + 2 * tw + j) * 1024 + lane * 16) = w; } } } while (0)
#define G2D_BAR() do { asm volatile("s_waitcnt vmcnt(0) lgkmcnt(0)" ::: "memory"); __syncthreads(); } while (0)
    for (int uu = F.bid; uu < 256; uu += F.G) {
        const int bh = uu & 7, vq = (uu >> 3) & 3, grp = uu >> 5;
        const size_t ubase = (size_t)bh * 128 + grp * G2_GRP;
        G2D_ISSUE_VKS(0); G2D_ISSUE_QF(0);
        f32x4 sa[4][4];
#pragma unroll
        for (int i = 0; i < 4; ++i)
#pragma unroll
            for (int nt = 0; nt < 4; ++nt) sa[i][nt] = (f32x4){0.f, 0.f, 0.f, 0.f};
#define G2F_LOAD(J_, TW_, DR_) do { const u32x4* ub_ = (const u32x4*)sloc + (size_t)(bh + 8 * vq + 32 * (J_)) * 4096; unsigned lj_ = (unsigned)lane; asm volatile("" : "+v"(lj_)); \
            _Pragma("unroll") for (int i = 0; i < 4; ++i) { DR_[i] = *(const f32x4*)(dec + ((size_t)bh * 128 + (J_) * G2_GRP + l15) * 256 + 16 * (d0 + i) + 4 * g); \
                _Pragma("unroll") for (int hh = 0; hh < 2; ++hh) { const u32x4 w4_ = (ub_ + (((d0 + i) * 2 + (n0 >> 2)) * 2 + hh) * 64)[lj_]; TW_[i][2 * hh] = (u32x2){w4_.x, w4_.y}; TW_[i][2 * hh + 1] = (u32x2){w4_.z, w4_.w}; } } } while (0)
#define G2F_FOLD(TW_, DR_) do { _Pragma("unroll") for (int i = 0; i < 4; ++i) { f32x4 d = DR_[i];     \
                _Pragma("unroll") for (int e = 0; e < 4; ++e) { float v = d[e]; v *= swz_<1>(v); v *= swz_<2>(v); v *= swz_<4>(v); v *= swz_<8>(v); d[e] = v; } \
                _Pragma("unroll") for (int nt = 0; nt < 4; ++nt) { const u32x2 w = TW_[i][nt]; sa[i][nt] = sa[i][nt] * d + (f32x4){bf_lo(w.x), bf_hi(w.x), bf_lo(w.y), bf_hi(w.y)}; } } } while (0)
        if (grp > 0) {
            u32x2 twA[4][4], twB[4][4]; f32x4 drA[4], drB[4];
            G2F_LOAD(0, twA, drA);
#pragma unroll 1
            for (int j = 0; j < grp; j += 2) {
                if (j + 1 < grp) G2F_LOAD(j + 1, twB, drB);
                __builtin_amdgcn_sched_barrier(0);
                G2F_FOLD(twA, drA);
                if (j + 1 < grp) {
                    if (j + 2 < grp) G2F_LOAD(j + 2, twA, drA);
                    __builtin_amdgcn_sched_barrier(0);
                    G2F_FOLD(twB, drB);
                }
            }
        }
#undef G2F_LOAD
#undef G2F_FOLD
        G2D_PUBLISH();
        G2D_BAR();
#pragma unroll 1
        for (int cc = 0; cc < G2_GRP; ++cc) {
            const int c = grp * G2_GRP + cc;
            f32x4 DC[4];
            { const float* dcu = dec + (ubase + cc) * 256 + 16 * d0;
#pragma unroll
              for (int i = 0; i < 4; ++i) DC[i] = *(const f32x4*)(dcu + (4 * g + 16 * i)); }
            f32x4 o[4];
#pragma unroll
            for (int ntl = 0; ntl < 4; ++ntl) o[ntl] = (f32x4){0.f, 0.f, 0.f, 0.f};
#pragma unroll
            for (int kk = 0; kk < 8; ++kk) {
                const bf16x8 qf = *(const LAS bf16x8*)(lds + G2L_QF + (tw * 8 + kk) * 1024 + lane * 16);
#pragma unroll
                for (int ntl = 0; ntl < 4; ++ntl) { const bf16x8 sb = *(const LAS bf16x8*)(lds + G2L_SB + ((n0 + ntl) * 8 + kk) * 1024 + lane * 16); o[ntl] = __builtin_amdgcn_mfma_f32_16x16x32_bf16(qf, sb, o[ntl], 0, 0, 0); }
            }
            G2D_BAR();
            if (cc + 1 < G2_GRP) G2D_ISSUE_QF(cc + 1);
            bf16x8 VT[4][2];
#pragma unroll
            for (int nt = 0; nt < 4; ++nt)
#pragma unroll
                for (int kk = 0; kk < 2; ++kk) VT[nt][kk] = *(const LAS bf16x8*)(lds + G2L_VT + ((n0 + nt) * 2 + kk) * 1024 + lane * 16);
            { const bf16x8 s0 = *(const LAS bf16x8*)(lds + G2L_SC + (tw * 2 + 0) * 1024 + lane * 16), s1 = *(const LAS bf16x8*)(lds + G2L_SC + (tw * 2 + 1) * 1024 + lane * 16);
#pragma unroll
              for (int ntl = 0; ntl < 4; ++ntl) {
                o[ntl] = __builtin_amdgcn_mfma_f32_16x16x32_bf16(s0, VT[ntl][0], o[ntl], 0, 0, 0);
                o[ntl] = __builtin_amdgcn_mfma_f32_16x16x32_bf16(s1, VT[ntl][1], o[ntl], 0, 0, 0);
                bf16* od = oraw + ((size_t)(bh * 32 + vq * 8 + n0 + ntl) * SEQ + c * CHUNK + 16 * tw + 4 * g) * 16 + l15;
#pragma unroll
                for (int r = 0; r < 4; ++r) od[r * 16] = (bf16)(cvt_pk_bf16(o[ntl][r], 0.f) & 0xffffu);
              } }
#pragma unroll
            for (int i = 0; i < 4; ++i) {
                const bf16x8 k0 = *(const LAS bf16x8*)(lds + G2L_KD + ((d0 + i) * 2 + 0) * 1024 + lane * 16), k1 = *(const LAS bf16x8*)(lds + G2L_KD + ((d0 + i) * 2 + 1) * 1024 + lane * 16);
#pragma unroll
                for (int nt = 0; nt < 4; ++nt) { sa[i][nt] = sa[i][nt] * DC[i];
                    sa[i][nt] = __builtin_amdgcn_mfma_f32_16x16x32_bf16(k0, VT[nt][0], sa[i][nt], 0, 0, 0);
                    sa[i][nt] = __builtin_amdgcn_mfma_f32_16x16x32_bf16(k1, VT[nt][1], sa[i][nt], 0, 0, 0); }
            }
            G2D_PUBLISH();
            G2D_BAR();
            if (cc + 1 < G2_GRP) G2D_ISSUE_VKS(cc + 1);
        }
        G2D_BAR();
    }
#undef G2D_COPY
#undef G2D_ISSUE_QF
#undef G2D_ISSUE_VKS
#undef G2D_PUBLISH
#undef G2D_BAR
}

__device__ __forceinline__ void p8_gla3(const Params& p, const Frame& F) {
    const int gw = F.bid * NWAVES + F.wave, NGW = F.G * NWAVES, lane = F.lane;
    const bf16* oraw = (const bf16*)(p.ws + WS_DQ); const bf16* gr = (const bf16*)(p.ws + WS_GR); bf16* yg = (bf16*)(p.ws + WS_S2);
    const f32x4 g0 = ((const f32x4*)KARG_IN(I_GONORM))[2 * lane], g1 = ((const f32x4*)KARG_IN(I_GONORM))[2 * lane + 1];
    const float gg[8] = {g0.x, g0.y, g0.z, g0.w, g1.x, g1.y, g1.z, g1.w};
    for (int m4 = gw * 4; m4 < M; m4 += NGW * 4) {
        const int b = m4 >> 13, t4 = m4 & (SEQ - 1);
        u32x4 ow[4][4], rw[4][4];
#pragma unroll
        for (int k = 0; k < 4; ++k)
#pragma unroll
            for (int hh = 0; hh < GH; ++hh) {
                ow[k][hh] = *(const u32x4*)(oraw + ((size_t)((b * GH + hh) * 32 + (lane >> 1)) * SEQ + t4 + k) * 16 + (lane & 1) * 8);
                rw[k][hh] = *((const u32x4*)(gr + (size_t)(m4 + k) * DM + hh * GDV) + lane); }
#pragma unroll
        for (int k = 0; k < 4; ++k)
#pragma unroll
            for (int hh = 0; hh < GH; ++hh) {
                const u32x4 a = ow[k][hh], rr = rw[k][hh];
                float o[8] = {bf_lo(a.x), bf_hi(a.x), bf_lo(a.y), bf_hi(a.y), bf_lo(a.z), bf_hi(a.z), bf_lo(a.w), bf_hi(a.w)};
                const float r[8] = {bf_lo(rr.x), bf_hi(rr.x), bf_lo(rr.y), bf_hi(rr.y), bf_lo(rr.z), bf_hi(rr.z), bf_lo(rr.w), bf_hi(rr.w)};
                float ss = 0.f;
#pragma unroll
                for (int e = 0; e < 8; ++e) ss += o[e] * o[e];
                const float rstd = rsqrtf(wave_sum(ss) * (1.f / GDV) + EPS);
#pragma unroll
                for (int e = 0; e < 8; ++e) o[e] = o[e] * rstd * gg[e] * (r[e] * sigmoidf_(r[e]));
                u32x4 w; w.x = cvt_pk_bf16(o[0], o[1]); w.y = cvt_pk_bf16(o[2], o[3]); w.z = cvt_pk_bf16(o[4], o[5]); w.w = cvt_pk_bf16(o[6], o[7]);
                *((u32x4*)(yg + (size_t)(m4 + k) * DM + hh * GDV) + lane) = w;
            }
    }
}

__device__ __forceinline__ void xa_vt_relayout(const Params& p, const Frame& F) {
    const bf16* kv = (const bf16*)(p.ws + WS_KV); bf16* vT = (bf16*)(p.ws + WS_VT);
    const int tid = F.tid;
    for (int it = F.bid; it < NB * XH * 16; it += F.G) {
        const int ds = it & 15, h = (it >> 4) & 3, b = it >> 6;
        __syncthreads();
#pragma unroll
        for (int i = 0; i < 2; ++i) { const int e = tid + 512 * i, mem = e >> 2, ch = e & 3;
            *(LAS u32x4*)(F.lds + mem * 80 + ch * 16) = *(const u32x4*)(kv + (size_t)(b * NMEM + mem) * 4096 + 2048 + h * XDH + ds * 32 + ch * 8); }
        __syncthreads();
        const int d = tid >> 4, p0 = (tid & 15) * 16;
        unsigned w[8];
#pragma unroll
        for (int q = 0; q < 8; ++q) {
            const int pa = p0 + 2 * q, pb = pa + 1;
            const int ma = (pa & ~31) + 16 * ((pa >> 2) & 1) + 4 * ((pa >> 3) & 3) + (pa & 3), mb = (pb & ~31) + 16 * ((pb >> 2) & 1) + 4 * ((pb >> 3) & 3) + (pb & 3);
            const unsigned lo = *(const LAS bf16*)(F.lds + ma * 80 + d * 2), hi = *(const LAS bf16*)(F.lds + mb * 80 + d * 2);
            w[q] = lo | (hi << 16); }
        bf16* o = vT + ((size_t)((b * XH + h) * XDH + ds * 32 + d)) * NMEM + p0;
#pragma unroll
        for (int q = 0; q < 2; ++q) *(u32x4*)(o + 8 * q) = (u32x4){w[4 * q], w[4 * q + 1], w[4 * q + 2], w[4 * q + 3]};
    }
    __syncthreads();
}
constexpr int XA_KROW = 1056, XA_KBUF = 32 * XA_KROW, XA_VROW = 544, XA_VBUF = 32 * XA_VROW, XA_VOFF = 2 * XA_KBUF;
static_assert(XA_VOFF + 2 * XA_VBUF <= MISC_OFF, "xa lds");
__device__ __forceinline__ void p13_xattn(const Params& p, const Frame& F) {
    const int lane = F.lane, wave = F.wave, tid = F.tid, g = lane >> 4, l15 = lane & 15;
    const bf16* qx = (const bf16*)(p.ws + WS_YDSA); const bf16* kv = (const bf16*)(p.ws + WS_KV); const bf16* vT = (const bf16*)(p.ws + WS_VT);
    bf16* o = (bf16*)(p.ws + WS_IQ);
    LAS unsigned char* lds = F.lds;
    const float SCL = 0.044194173824159216f;
    for (int uu = F.bid; uu < 512; uu += F.G) {
        const int b = uu >> 8, h = (uu >> 6) & 3, tb = uu & 63; const size_t m0 = (size_t)b * SEQ + tb * 128 + wave * 16;
        bf16x8 bq[16];
        { const bf16* qs = qx + (m0 + l15) * DM + h * XDH + 8 * g;
#pragma unroll
          for (int kk = 0; kk < 16; ++kk) bq[kk] = *(const bf16x8*)(qs + 32 * kk); }
        const bf16* kbase = kv + (size_t)(b * NMEM) * 4096 + h * XDH;
        const bf16* vbase = vT + (size_t)(b * XH + h) * XDH * NMEM;
        u32x4 st[2][4];
#define XA_KLOAD(KT_, S_) do { _Pragma("unroll") for (int i = 0; i < 4; ++i) { const int e = tid + 512 * i, row = e >> 6, ch = e & 63; st[S_][i] = *(const u32x4*)(kbase + (size_t)(32 * (KT_) + row) * 4096 + ch * 8); } } while (0)
#define XA_KPUT(KT_, S_) do { LAS unsigned char* nb_ = lds + ((KT_) & 1) * XA_KBUF; _Pragma("unroll") for (int i = 0; i < 4; ++i) { const int e = tid + 512 * i, row = e >> 6, ch = e & 63; *(LAS u32x4*)(nb_ + row * XA_KROW + ch * 16) = st[S_][i]; } } while (0)
        XA_KLOAD(0, 0);
        XA_KPUT(0, 0);
        __syncthreads();
        f32x4 sT[16];
#pragma unroll
        for (int kt = 0; kt < 8; ++kt) {
            LAS unsigned char* kb = lds + (kt & 1) * XA_KBUF;
            if (kt + 1 < 8) { XA_KLOAD(kt + 1, 0); __builtin_amdgcn_sched_barrier(0); }
#pragma unroll
            for (int sub = 0; sub < 2; ++sub) {
                f32x4 a4 = (f32x4){0.f, 0.f, 0.f, 0.f};
#pragma unroll
                for (int kk = 0; kk < 16; ++kk) { const bf16x8 a = *(const LAS bf16x8*)(kb + (16 * sub + l15) * XA_KROW + kk * 64 + g * 16); a4 = __builtin_amdgcn_mfma_f32_16x16x32_bf16(a, bq[kk], a4, 0, 0, 0); }
                sT[2 * kt + sub] = a4;
            }
            if (kt + 1 < 8) XA_KPUT(kt + 1, 0);
            __syncthreads();
        }
#undef XA_KLOAD
#undef XA_KPUT
#define XA_VLOAD(VT_, S_) do { _Pragma("unroll") for (int i = 0; i < 2; ++i) { const int e = tid + 512 * i, row = e >> 5, ch = e & 31; st[S_][i] = *(const u32x4*)(vbase + (size_t)(32 * (VT_) + row) * NMEM + ch * 8); } } while (0)
#define XA_VPUT(VT_, S_) do { LAS unsigned char* nb_ = lds + XA_VOFF + ((VT_) & 1) * XA_VBUF; _Pragma("unroll") for (int i = 0; i < 2; ++i) { const int e = tid + 512 * i, row = e >> 5, ch = e & 31; *(LAS u32x4*)(nb_ + row * XA_VROW + ch * 16) = st[S_][i]; } } while (0)
        XA_VLOAD(0, 0); XA_VLOAD(1, 1);
        __builtin_amdgcn_sched_barrier(0);
        float mx = -INFINITY;
#pragma unroll
        for (int mt = 0; mt < 16; ++mt) mx = fmaxf(mx, fmaxf(fmaxf(sT[mt][0], sT[mt][1]), fmaxf(sT[mt][2], sT[mt][3])));
        mx = x16_max(mx); mx = x32_max(mx);
        float sum = 0.f;
#pragma unroll
        for (int mt = 0; mt < 16; ++mt) {
#pragma unroll
            for (int r = 0; r < 4; ++r) { const float e = __expf((sT[mt][r] - mx) * SCL); sT[mt][r] = e; sum += e; } }
        sum = x16_sum(sum); sum = x32_sum(sum);
        const float inv = __frcp_rn(sum);
        bf16x8 pf[8];
#pragma unroll
        for (int kk = 0; kk < 8; ++kk) { u32x4 w; w.x = cvt_pk_bf16(sT[2 * kk][0], sT[2 * kk][1]); w.y = cvt_pk_bf16(sT[2 * kk][2], sT[2 * kk][3]); w.z = cvt_pk_bf16(sT[2 * kk + 1][0], sT[2 * kk + 1][1]); w.w = cvt_pk_bf16(sT[2 * kk + 1][2], sT[2 * kk + 1][3]);
            pf[kk] = __builtin_bit_cast(bf16x8, w); }
        XA_VPUT(0, 0);
        __syncthreads();
        bf16* od = o + (m0 + l15) * DM + h * XDH + 4 * g;
#pragma unroll 2
        for (int vt = 0; vt < 16; ++vt) {
            LAS unsigned char* vb = lds + XA_VOFF + (vt & 1) * XA_VBUF;
            if (vt + 2 < 16) { XA_VLOAD(vt + 2, vt & 1); __builtin_amdgcn_sched_barrier(0); }
#pragma unroll
            for (int sub = 0; sub < 2; ++sub) {
                f32x4 a4 = (f32x4){0.f, 0.f, 0.f, 0.f};
#pragma unroll
                for (int kk = 0; kk < 8; ++kk) { const bf16x8 a = *(const LAS bf16x8*)(vb + (16 * sub + l15) * XA_VROW + kk * 64 + g * 16); a4 = __builtin_amdgcn_mfma_f32_16x16x32_bf16(a, pf[kk], a4, 0, 0, 0); }
                u32x2 w; w.x = cvt_pk_bf16(a4[0] * inv, a4[1] * inv); w.y = cvt_pk_bf16(a4[2] * inv, a4[3] * inv);
                *(u32x2*)(od + 16 * (2 * vt + sub)) = w;
            }
            if (vt + 1 < 16) XA_VPUT(vt + 1, (vt + 1) & 1);
            __syncthreads();
        }
#undef XA_VLOAD
#undef XA_VPUT
    }
}

__device__ __forceinline__ float pval_(unsigned u, int mode) {
    float v = mode == 1 ? (float)(u >> 16) * (1.f / 8192.f) : mode == 2 ? __uint_as_float(u) : bf_hi(u);
    if (!(v == v)) v = 3.f;
    return fminf(fmaxf(v, -4.f), 4.f);
}
struct PReg { int a, b, mode; };
template <int K> __device__ __forceinline__ void probe_run(const Params& p, int bid, int G, int wave) {
    constexpr PReg R[19][4] = {
        {{1, 7, 0}, {64, 122, 0}, {128, 192, 0}, {0, 0, 0}},
        {{192, 320, 0}, {27, 59, 2}, {0, 0, 0}, {0, 0, 0}},
        {{7, 19, 0}, {-1, 0, 0}, {0, 0, 0}, {0, 0, 0}},
        {{19, 27, 1}, {0, 0, 0}, {0, 0, 0}, {0, 0, 0}},
        {{-1, 0, 0}, {0, 0, 0}, {0, 0, 0}, {0, 0, 0}},
        {{448, 512, 0}, {0, 0, 0}, {0, 0, 0}, {0, 0, 0}},
        {{192, 384, 0}, {-1, 0, 0}, {0, 0, 0}, {0, 0, 0}},
        {{128, 192, 0}, {384, 448, 0}, {64, 96, 0}, {27, 28, 2}},
        {{256, 320, 0}, {0, 0, 0}, {0, 0, 0}, {0, 0, 0}},
        {{128, 192, 0}, {384, 416, 0}, {0, 0, 0}, {0, 0, 0}},
        {{-1, 0, 0}, {192, 256, 0}, {104, 108, 0}, {0, 0, 0}},
        {{448, 512, 0}, {108, 110, 0}, {0, 0, 0}, {0, 0, 0}},
        {{-1, 0, 2}, {128, 192, 0}, {256, 322, 0}, {0, 0, 0}},
        {{448, 512, 0}, {0, 0, 0}, {0, 0, 0}, {0, 0, 0}},
        {{192, 256, 0}, {0, 0, 0}, {0, 0, 0}, {0, 0, 0}},
        {{448, 512, 0}, {0, 0, 0}, {0, 0, 0}, {0, 0, 0}},
        {{-1, 0, 2}, {128, 192, 0}, {0, 0, 0}, {0, 0, 0}},
        {{328, 504, 0}, {0, 0, 0}, {0, 0, 0}, {0, 0, 0}},
        {{192, 256, 0}, {0, 0, 0}, {0, 0, 0}, {0, 0, 0}},
    };
    const int gt = bid * NTHR + wave * 64 + fresh_lane(), NT = G * NTHR;
    float* tmp = (float*)(p.ws + 512 * 1024);
    float ds = 0.f; bool has_d = false;
#pragma unroll
    for (int r = 0; r < 4; ++r) if (R[K][r].a < 0) { has_d = true; const unsigned* o32 = (const unsigned*)p.out; for (int j = gt; j < M * DM; j += NT) ds += pval_(o32[j], R[K][r].mode); }
    if (has_d) tmp[gt & 131071] = ds * (1.f / 64.f);
}
template <int K> __device__ __forceinline__ void probe_out(const Params& p, int bid, int G, int wave) {
    constexpr PReg R[19][4] = {
        {{1, 7, 0}, {64, 122, 0}, {128, 192, 0}, {0, 0, 0}}, {{192, 320, 0}, {27, 59, 2}, {0, 0, 0}, {0, 0, 0}}, {{7, 19, 0}, {-1, 0, 0}, {0, 0, 0}, {0, 0, 0}}, {{19, 27, 1}, {0, 0, 0}, {0, 0, 0}, {0, 0, 0}},
        {{-1, 0, 0}, {0, 0, 0}, {0, 0, 0}, {0, 0, 0}}, {{448, 512, 0}, {0, 0, 0}, {0, 0, 0}, {0, 0, 0}}, {{192, 384, 0}, {-1, 0, 0}, {0, 0, 0}, {0, 0, 0}}, {{128, 192, 0}, {384, 448, 0}, {64, 96, 0}, {27, 28, 2}},
        {{256, 320, 0}, {0, 0, 0}, {0, 0, 0}, {0, 0, 0}}, {{128, 192, 0}, {384, 416, 0}, {0, 0, 0}, {0, 0, 0}}, {{-1, 0, 0}, {192, 256, 0}, {104, 108, 0}, {0, 0, 0}}, {{448, 512, 0}, {108, 110, 0}, {0, 0, 0}, {0, 0, 0}},
        {{-1, 0, 2}, {128, 192, 0}, {256, 322, 0}, {0, 0, 0}}, {{448, 512, 0}, {0, 0, 0}, {0, 0, 0}, {0, 0, 0}}, {{192, 256, 0}, {0, 0, 0}, {0, 0, 0}, {0, 0, 0}}, {{448, 512, 0}, {0, 0, 0}, {0, 0, 0}, {0, 0, 0}},
        {{-1, 0, 2}, {128, 192, 0}, {0, 0, 0}, {0, 0, 0}}, {{328, 504, 0}, {0, 0, 0}, {0, 0, 0}, {0, 0, 0}}, {{192, 256, 0}, {0, 0, 0}, {0, 0, 0}, {0, 0, 0}},
    };
    const int gt = bid * NTHR + wave * 64 + fresh_lane(), NT = G * NTHR;
    const float* tmp = (const float*)(p.ws + 512 * 1024);
    for (int i = gt; i < M * DM; i += NT) {
        float acc = 0.f;
#pragma unroll
        for (int r = 0; r < 4; ++r) {
            if (R[K][r].a < 0) acc += tmp[i & 131071];
            else if (R[K][r].b > R[K][r].a) { const unsigned* w32 = (const unsigned*)(p.ws + (size_t)R[K][r].a * MiB); const int nw = (R[K][r].b - R[K][r].a) * (int)(MiB / 4);
                for (int j = i; j < nw; j += M * DM) acc += pval_(w32[j], R[K][r].mode); }
        }
        p.out[i] = acc;
    }
}
#define PROBE_EXIT(k) do { if (STOP_AFTER == (k)) { probe_run<(k)>(p, F.bid, F.G, F.wave); GRID_BAR(); probe_out<(k)>(p, F.bid, F.G, F.wave); return; } } while (0)


__device__ __forceinline__ void l2_scrub(const float* x, int bid, int tid) {
    const f32x4* s = (const f32x4*)x + (size_t)(bid & 255) * 32768 + tid; f32x4 a = (f32x4){0.f, 0.f, 0.f, 0.f};
#pragma unroll 8
    for (int i = 0; i < 64; ++i) { const f32x4 v = __builtin_nontemporal_load(s + i * 512); a += v; }
    asm volatile("" :: "v"(a.x + a.y + a.z + a.w));
}

#define NONDET_TEST 0
#ifndef DBL_MASK
#define DBL_MASK 0
#ifndef TP_OFF_US
#define TP_OFF_US 0.0f
#define TP_DIV_US 5.0f
#endif
#endif
#define L2_SCRUB 0
#define G2_TWICE 0
#define NAN_SCRUB 0
#define P11_NOCONV 0
#ifndef PH_MASK
#define PH_MASK 0xffffffffu
#endif
#ifndef STOP_AFTER
#define STOP_AFTER 99
#endif
__global__ void __launch_bounds__(NTHR, 2) fwd_kernel(Params p) {
    extern __shared__ __attribute__((aligned(16))) unsigned char lds_raw[];
    Frame F;
    F.lds = (LAS unsigned char*)lds_raw;
    F.tid = threadIdx.x; F.lane = F.tid & 63; F.wave = __builtin_amdgcn_readfirstlane(F.tid >> 6);
    F.G = gridDim.x; F.bid = blockIdx.x;
    volatile LAS unsigned* MISC = (volatile LAS unsigned*)(F.lds + MISC_OFF);
    if (F.tid < 64) MISC[F.tid] = 0u;
    __syncthreads();
    unsigned char* ws = p.ws;
    XcdBarrier bar = xcd_barrier_post((unsigned*)(ws + WS_CTL) + CW_BAR, MISC + 8, F.wave);
#ifndef TP_WORK
#define TP_WORK 0
#endif
#ifndef TP_ARGMIN
#define TP_ARGMIN 0
#endif
#ifndef TP_BLK
#define TP_BLK -1
#endif
#ifndef TP_BARLO
#define TP_BARLO -1
#define TP_BARHI -1
#endif
#if TP_BARLO >= 0
#define GRID_BAR() do { const unsigned long long tb0_ = __builtin_amdgcn_s_memrealtime(); xcd_barrier(bar); const unsigned long long tb1_ = __builtin_amdgcn_s_memrealtime(); \
        if (F.wave == 0 && fresh_lane() == 0) { const unsigned bi_ = MISC[21]; MISC[21] = bi_ + 1u; if (bi_ >= TP_BARLO && bi_ < TP_BARHI) MISC[20] = MISC[20] + (TP_WORK ? (unsigned)tb0_ - MISC[22] : (unsigned)(tb1_ - tb0_)); MISC[22] = (unsigned)tb1_; } } while (0)
#else
#define GRID_BAR() xcd_barrier(bar)
#endif
#define FRESH() const int l_ = fresh_lane(); F.lane = l_; F.tid = F.wave * 64 + l_; \
    LAS float* cscr = (LAS float*)(F.lds + F.wave * 16384); const int gw = F.bid * NWAVES + F.wave, NGW = F.G * NWAVES; (void)cscr; (void)gw; (void)NGW
    bf16* S1 = (bf16*)(ws + WS_S1); (void)S1;
    bf16* U = (bf16*)(ws + WS_S2);
    bf16* B3 = (bf16*)(ws + WS_S3);
    bf16* B4 = (bf16*)(ws + WS_S4);
    bf16* B5 = (bf16*)(ws + WS_S5);
    bf16* B7 = (bf16*)(ws + WS_S7);
    bf16* OUTB = (bf16*)p.out;
    pg8::StaticOrder SO;

    { FRESH(); TPR_BEGIN(5); if (PH_MASK & (1u << 0)) p0_prologue(p, F); if (DBL_MASK & 32) p0_prologue(p, F); TPR_END(5); }
    GRID_BAR();
    PROBE_EXIT(0);
    { pg8::Gemm g{U, (const bf16*)(ws + WS_W1A), M, 4608, DM, DM, 0, 0}; SO.init(M, 4608, F.G, F.bid);
      pg8::EpiP1a E{B3, B4, (float*)(ws + WS_DCRAW), (float*)(ws + WS_MISC)};
      pg8::gemm_phase<pg8::EpiP1a, pg8::StaticOrder>(F.lds, g, SO, E, F.wave); }
    { pg8::Gemm g{(const bf16*)(ws + WS_MEMN), (const bf16*)(ws + WS_WXKV0), NB * NMEM, 2 * DM, DM, DM, 0, 0}; SO.init(NB * NMEM, 2 * DM, F.G, (F.G == 256 && F.bid >= 128) ? F.bid - 128 : (F.G == 256 ? (1 << 20) : F.bid));
      pg8::EpiPlain E{(bf16*)(ws + WS_KV), 2 * DM};
      pg8::gemm_phase<pg8::EpiPlain, pg8::StaticOrder>(F.lds, g, SO, E, F.wave); }
    { FRESH(); __syncthreads();
      if (F.G != 256) p0_late(p, F, gw, NGW); else if (F.bid >= 160) p0_late(p, F, (F.bid - 160) * NWAVES + F.wave, 96 * NWAVES); }
    GRID_BAR();
    PROBE_EXIT(1);
    { FRESH(); if (PH_MASK & (1u << 1)) p2_norms(p, F); }
    { pg8::Gemm g{B4, (const bf16*)(ws + WS_BTUK), M, 4096, 256, DM, 256, 1}; SO.init(M, 4096, F.G, F.bid);
      pg8::EpiPlain E{OUTB, 4096};
      pg8::gemm_phase<pg8::EpiPlain, pg8::StaticOrder>(F.lds, g, SO, E, F.wave); }
    GRID_BAR();
    PROBE_EXIT(2);
    { FRESH(); TPR_BEGIN(4); if (F.G == 256) p3_score_both(p, F); else if (PH_MASK & (1u << 2)) p3_indexer<(DBL_MASK & 1) ? 2 : 1>(p, F); TPR_END(4);
      VM_WAIT(); __builtin_amdgcn_fence(__ATOMIC_ACQUIRE, "agent"); VM_WAIT(); __syncthreads();
      { TPR_BEGIN(3); if (F.G == 256) p4_dsa<true>(p, F); else if (PH_MASK & (1u << 3)) p4_dsa<false>(p, F); TPR_END(3); } }
    GRID_BAR();
    PROBE_EXIT(4);
    { pg8::Gemm g{OUTB, (const bf16*)(ws + WS_BTUV), M, DM, 512, 4096, 512, 0}; SO.init(M, DM, F.G, F.bid);
      pg8::EpiPlain E{B7, DM};
      pg8::gemm_phase<pg8::EpiPlain, pg8::StaticOrder>(F.lds, g, SO, E, F.wave); }
    GRID_BAR();
    PROBE_EXIT(5);
    { pg8::Gemm g{U, (const bf16*)(ws + WS_W1B), M, 10240, DM, DM, 0, 0}; SO.init(M, 10240, F.G, F.bid);
      pg8::EpiP1b E{B3, B4, B5, OUTB, OUTB + (size_t)M * DM};
      pg8::gemm_phase<pg8::EpiP1b, pg8::StaticOrder>(F.lds, g, SO, E, F.wave); }
    GRID_BAR();
    PROBE_EXIT(6);
    { FRESH(); int rot = 1024; if (PH_MASK & (1u << 4)) p6_gla1(p, F); if (DBL_MASK & 2) p6_gla1(p, F);
    conv_seg(KARG_IN(I_WGB), DM, DM, 0, DM, (bf16*)(ws + WS_WGB), DM, 0, 0, cscr, gw, NGW, F.lane, rot);
    conv_seg(KARG_IN(I_WDB), DM, DM, 0, DM, (bf16*)(ws + WS_WDB), DM, 0, 0, cscr, gw, NGW, F.lane, rot);
    conv_seg(KARG_IN(I_WMIX), DM, DM, 0, DM, (bf16*)(ws + WS_WMIX), DM, 0, 0, cscr, gw, NGW, F.lane, rot); }
    GRID_BAR();
    PROBE_EXIT(7);
    { FRESH(); gla_scan_state(p, F); if (DBL_MASK & 4) gla_scan_state(p, F); }
    GRID_BAR();
    { FRESH(); gla_scan_full(p, F, (bf16*)(ws + WS_DQ)); if (DBL_MASK & 256) gla_scan_full(p, F, (bf16*)(ws + WS_DQ)); }
    GRID_BAR();
    PROBE_EXIT(8);
    { FRESH(); int rot = 0; if (L2_SCRUB) l2_scrub(KARG_IN(I_X), F.bid, F.tid); if (PH_MASK & (1u << 6)) p8_gla3(p, F); if (DBL_MASK & 8) p8_gla3(p, F);
    conv_seg(KARG_IN(I_WXQ), DM, DM, 0, DM, (bf16*)(ws + WS_WXQ), DM, 0, 0, cscr, gw, NGW, F.lane, rot);
    conv_seg(KARG_IN(I_WXO), DM, DM, 0, DM, (bf16*)(ws + WS_WXO), DM, 0, 0, cscr, gw, NGW, F.lane, rot); }
    GRID_BAR();
    PROBE_EXIT(9);
    { pg8::Gemm g{B7, (const bf16*)(ws + WS_WDB), M, DM, DM, DM, 0, 0}; SO.init(M, DM, F.G, F.bid);
      pg8::EpiGateMul E{OUTB + (size_t)M * DM};
      pg8::gemm_phase<pg8::EpiGateMul, pg8::StaticOrder>(F.lds, g, SO, E, F.wave); }
    { pg8::Gemm g{U, (const bf16*)(ws + WS_WGB), M, DM, DM, DM, 0, 0}; SO.init(M, DM, F.G, F.bid);
      pg8::EpiMerge E{OUTB, OUTB + (size_t)M * DM, B3};
      pg8::gemm_phase<pg8::EpiMerge, pg8::StaticOrder>(F.lds, g, SO, E, F.wave); }
    GRID_BAR();
    PROBE_EXIT(10);
    { pg8::Gemm g{B3, (const bf16*)(ws + WS_WMIX), M, DM, DM, DM, 0, 0}; SO.init(M, DM, F.G, F.bid);
      pg8::EpiPlain E{B7, DM};
      pg8::gemm_phase<pg8::EpiPlain, pg8::StaticOrder>(F.lds, g, SO, E, F.wave); }
    { FRESH(); xa_vt_relayout(p, F); }
    GRID_BAR();
    PROBE_EXIT(11);
    { FRESH(); for (int m = gw; m < M; m += 2 * NGW) { if (m + NGW < M) resid_rows<false, true, 2>(KARG_IN(I_X), B7, KARG_IN(I_MIXPOST), (bf16*)p.out, KARG_IN(I_XAPRE), U, (size_t)m, (size_t)NGW, F.lane); else resid_rows<false, true, 1>(KARG_IN(I_X), B7, KARG_IN(I_MIXPOST), (bf16*)p.out, KARG_IN(I_XAPRE), U, (size_t)m, (size_t)NGW, F.lane); }
    if (!P11_NOCONV) for (int it = gw; it < 88 * 64; it += NGW) { const int jj = it >> 6, sub = it & 63;
        conv_item((jj & 1) ? KARG_IN(I_WFU) : KARG_IN(I_WFG), DFF, (jj >> 1) * 128, 128, (bf16*)(ws + WS_WFGU), DM, 0, (jj >> 1) * 256 + (jj & 1) * 128, cscr, sub, F.lane); }
    { int rot = (88 * 64) % NGW; if (!P11_NOCONV) conv_seg(KARG_IN(I_WFD), DM, DFF, 0, DM, (bf16*)(ws + WS_WFD), DFF, 0, 0, cscr, gw, NGW, F.lane, rot); } }
    GRID_BAR();
    PROBE_EXIT(12);
    { pg8::Gemm g{U, (const bf16*)(ws + WS_WXQ), M, DM, DM, DM, 0, 0}; SO.init(M, DM, F.G, F.bid);
      pg8::EpiPlain E{B7, DM};
      pg8::gemm_phase<pg8::EpiPlain, pg8::StaticOrder>(F.lds, g, SO, E, F.wave); }
    GRID_BAR();
    PROBE_EXIT(13);
    { FRESH(); if (PH_MASK & (1u << 7)) p13_xattn(p, F); if (DBL_MASK & 16) p13_xattn(p, F); }
    GRID_BAR();
    PROBE_EXIT(14);
    { pg8::Gemm g{B3, (const bf16*)(ws + WS_WXO), M, DM, DM, DM, 0, 0}; SO.init(M, DM, F.G, F.bid);
      pg8::EpiPlain E{B7, DM};
      pg8::gemm_phase<pg8::EpiPlain, pg8::StaticOrder>(F.lds, g, SO, E, F.wave); }
    GRID_BAR();
    PROBE_EXIT(15);
    { FRESH(); for (int m = gw; m < M; m += 2 * NGW) { if (m + NGW < M) resid_rows<true, true, 2>((const bf16*)p.out, B7, KARG_IN(I_XAPOST), (bf16*)(ws + WS_S1), KARG_IN(I_FFPRE), U, (size_t)m, (size_t)NGW, F.lane); else resid_rows<true, true, 1>((const bf16*)p.out, B7, KARG_IN(I_XAPOST), (bf16*)(ws + WS_S1), KARG_IN(I_FFPRE), U, (size_t)m, (size_t)NGW, F.lane); } }
    GRID_BAR();
    PROBE_EXIT(16);
    { pg8::Gemm g{U, (const bf16*)(ws + WS_WFGU), M, 2 * DFF, DM, DM, 0, 0}; SO.init(M, 2 * DFF, F.G, F.bid);
      pg8::EpiSwiglu E{(bf16*)(ws + WS_HID)};
      pg8::gemm_phase<pg8::EpiSwiglu, pg8::StaticOrder>(F.lds, g, SO, E, F.wave);
      if (DBL_MASK & 64) pg8::gemm_phase<pg8::EpiSwiglu, pg8::StaticOrder>(F.lds, g, SO, E, F.wave); }
    GRID_BAR();
    PROBE_EXIT(17);
    { pg8::Gemm g{(const bf16*)(ws + WS_HID), (const bf16*)(ws + WS_WFD), M, DM, DFF, DFF, 0, 0}; SO.init(M, DM, F.G, F.bid);
      pg8::EpiPlain E{B3, DM};
      pg8::gemm_phase<pg8::EpiPlain, pg8::StaticOrder>(F.lds, g, SO, E, F.wave); }
    GRID_BAR();
    PROBE_EXIT(18);
    { FRESH(); for (int m = gw; m < M; m += 2 * NGW) { if (m + NGW < M) resid_rows<true, false, 2>((const bf16*)(ws + WS_S1), B3, KARG_IN(I_FFPOST), p.out, nullptr, nullptr, (size_t)m, (size_t)NGW, F.lane); else resid_rows<true, false, 1>((const bf16*)(ws + WS_S1), B3, KARG_IN(I_FFPOST), p.out, nullptr, nullptr, (size_t)m, (size_t)NGW, F.lane); } }
#if SC_VAR >= 0 || TP_REGION > 0 || TP_BARLO >= 0
    { __syncthreads();
      if (TP_ARGMIN) { if (F.wave == 0 && fresh_lane() == 0) __hip_atomic_fetch_max((unsigned*)(ws + WS_CTL) + 64, ((0xFFFFFu - (MISC[20] > 0xFFFFFu ? 0xFFFFFu : MISC[20])) << 8) | (unsigned)F.bid, __ATOMIC_RELAXED, __HIP_MEMORY_SCOPE_AGENT); } else
      if (F.wave == 0 && fresh_lane() == 0 && (TP_BLK < 0 || F.bid == TP_BLK)) __hip_atomic_fetch_add((unsigned*)(ws + WS_CTL) + 64, MISC[20] * (TP_BLK < 0 ? 1u : 256u), __ATOMIC_RELAXED, __HIP_MEMORY_SCOPE_AGENT);
      xcd_barrier(bar);
      if (F.bid == 0 && F.wave == 0 && fresh_lane() == 0) { const unsigned tot = __hip_atomic_load((unsigned*)(ws + WS_CTL) + 64, __ATOMIC_RELAXED, __HIP_MEMORY_SCOPE_AGENT);
          p.out[0] = p.out[0] + (TP_ARGMIN ? (TP_ARGMIN == 2 ? (float)(0xFFFFFu - (tot >> 8)) * 0.01f / TP_DIV_US : (float)(tot & 255u) * 0.1f) + 1.0f : ((float)tot * (1.0f / 256.0f) * 0.01f - TP_OFF_US) * (1.0f / TP_DIV_US) + 1.0f); }
    }
#endif
#if NAN_SCRUB
    GRID_BAR();
    { const int gt = F.bid * NTHR + F.wave * 64 + fresh_lane(), NT = F.G * NTHR; for (int i = gt; i < M * DM; i += NT) { const float v = p.out[i]; if (!(fabsf(v) < 1e30f)) p.out[i] = 0.f; } }
#endif
}

extern "C" void kernel_launch(void* const* d_in, const int* in_sizes, int n_in, void* d_out, int out_size, void* d_ws, size_t ws_size, hipStream_t stream) {
    static int grid = 0;
    if (grid == 0) {
        if (n_in != 28 || out_size != M * DM || ws_size < WS_END) { fprintf(stderr, "kernel_launch: unexpected shapes (n_in %d out %d ws %zu)\n", n_in, out_size, ws_size); grid = -1; return; }
        int dev = 0, cus = 0;
        if (hipGetDevice(&dev) != hipSuccess || hipDeviceGetAttribute(&cus, hipDeviceAttributeMultiprocessorCount, dev) != hipSuccess) { grid = -1; return; }
        if (hipFuncSetAttribute((const void*)fwd_kernel, hipFuncAttributeMaxDynamicSharedMemorySize, LDS_BYTES) != hipSuccess) { fprintf(stderr, "kernel_launch: hipFuncSetAttribute failed\n"); grid = -1; return; }
        int per_cu = 0;
        if (hipOccupancyMaxActiveBlocksPerMultiprocessor(&per_cu, (const void*)fwd_kernel, NTHR, LDS_BYTES) != hipSuccess || per_cu < 1) fprintf(stderr, "kernel_launch: occupancy query says %d\n", per_cu);
        (void)hipGetLastError();
        grid = cus;
    }
    if (grid < 0) return;
    (void)in_sizes;
    hipMemsetAsync((char*)d_ws + WS_CTL, 0, CTL_ZERO_BYTES, stream);
    Params p{};
    for (int i = 0; i < 28; ++i) p.in[i] = (const float*)d_in[i];
    p.out = (float*)d_out; p.ws = (unsigned char*)d_ws;
    hipLaunchKernelGGL(fwd_kernel, dim3(grid), dim3(NTHR), LDS_BYTES, stream, p);
}
```
